# Optimizing an MI355X kernel written in HIP

```python
import jax, jax.numpy as jnp
from jax import lax
import numpy as np

D_MODEL = 1024
BATCH = 8
SEQ = 2048
DEPTH = 1

CTX_LEN = 256
GRID_W = 64
EPS = 1e-6

ATT_HEADS = 8
ATT_KV_HEADS = 2
ATT_GROUP = ATT_HEADS // ATT_KV_HEADS
ATT_HEAD_DIM = 64
WINDOW = 128
ATT_BLOCK = 128
ROPE_BASE = 10000.0
ROPE_AXIS_DIM = ATT_HEAD_DIM // 2

ML_HEADS = 4
ML_V_DIM = 128
ML_QK_DIM = 64
ML_CHUNK = 64
ML_CONV = 3

ATT_WIDTH = ATT_HEADS * ATT_HEAD_DIM
ATT_KV_WIDTH = ATT_KV_HEADS * ATT_HEAD_DIM
ML_WIDTH = ML_HEADS * ML_V_DIM
ML_QK_WIDTH = ML_HEADS * ML_QK_DIM
ML_GATES = 4 * ML_HEADS
MIX_WIDTH = ATT_WIDTH + ML_WIDTH
FFN_HIDDEN = -(-8 * D_MODEL // (3 * 256)) * 256

COLS = (ATT_WIDTH, ATT_KV_WIDTH, ATT_KV_WIDTH, ML_QK_WIDTH, ML_QK_WIDTH, ML_WIDTH, ML_WIDTH, ML_GATES)
IN_WIDTH = sum(COLS)
SPLIT_AT = tuple(sum(COLS[:i + 1]) for i in range(len(COLS) - 1))

kernel_name = 'hymba_style_mlstm_swa_sandwich_adaln_block'


def rms_norm(x, g):
    xf = x.astype(jnp.float32)
    y = xf * lax.rsqrt(jnp.mean(xf * xf, axis=-1, keepdims=True) + EPS)
    return (y * g.astype(jnp.float32)).astype(x.dtype)


def modulate(h, shift, scale):
    return h * (1.0 + scale) + shift


def axial_rope_tables(n_tokens, dtype):
    n_rows = n_tokens // GRID_W
    row = jnp.repeat(jnp.arange(n_rows, dtype=jnp.float32), GRID_W)
    col = jnp.tile(jnp.arange(GRID_W, dtype=jnp.float32), n_rows)
    half = ROPE_AXIS_DIM // 2
    inv_freq = jnp.power(ROPE_BASE, -jnp.arange(half, dtype=jnp.float32) / half)
    ang_r = row[:, None] * inv_freq
    ang_c = col[:, None] * inv_freq
    return tuple(t[:, None, :].astype(dtype) for t in (jnp.cos(ang_r), jnp.sin(ang_r), jnp.cos(ang_c), jnp.sin(ang_c)))


def axial_rope(x, cos_r, sin_r, cos_c, sin_c):
    def rot(u, cos, sin):
        u1, u2 = jnp.split(u, 2, axis=-1)
        return jnp.concatenate([u1 * cos - u2 * sin, u2 * cos + u1 * sin], axis=-1)
    xr, xc = jnp.split(x, 2, axis=-1)
    return jnp.concatenate([rot(xr, cos_r, sin_r), rot(xc, cos_c, sin_c)], axis=-1)


def window_attention(q, k, v, kc, vc, sink):
    B, S = q.shape[:2]
    nb = S // ATT_BLOCK
    scale = ATT_HEAD_DIM ** -0.5
    qb = q.reshape(B, nb, ATT_BLOCK, ATT_KV_HEADS, ATT_GROUP, ATT_HEAD_DIM)
    pad = ((0, 0), (ATT_BLOCK, ATT_BLOCK), (0, 0), (0, 0))

    def band(t):
        tp = jnp.pad(t, pad).reshape(B, nb + 2, ATT_BLOCK, ATT_KV_HEADS, ATT_HEAD_DIM)
        return jnp.concatenate([tp[:, :-2], tp[:, 1:-1], tp[:, 2:]], axis=2)

    kw, vw = band(k), band(v)
    qpos = jnp.arange(S).reshape(nb, ATT_BLOCK)
    kpos = (jnp.arange(nb)[:, None] - 1) * ATT_BLOCK + jnp.arange(3 * ATT_BLOCK)[None, :]
    valid = ((jnp.abs(qpos[:, :, None] - kpos[:, None, :]) <= WINDOW)
             & (kpos[:, None, :] >= 0) & (kpos[:, None, :] < S))
    s_loc = jnp.einsum('bnqhgd,bnkhd->bnhgqk', qb, kw).astype(jnp.float32) * scale
    s_loc = jnp.where(valid[None, :, None, None], s_loc, -jnp.inf)
    s_ctx = jnp.einsum('bnqhgd,bchd->bnhgqc', qb, kc).astype(jnp.float32) * scale
    sk = sink.astype(jnp.float32).reshape(1, 1, ATT_KV_HEADS, ATT_GROUP, 1, 1)
    m = jnp.maximum(jnp.maximum(s_loc.max(-1, keepdims=True), s_ctx.max(-1, keepdims=True)), sk)
    p_loc = jnp.exp(s_loc - m)
    p_ctx = jnp.exp(s_ctx - m)
    inv = 1.0 / (p_loc.sum(-1, keepdims=True) + p_ctx.sum(-1, keepdims=True) + jnp.exp(sk - m))
    o = (jnp.einsum('bnhgqk,bnkhd->bnqhgd', (p_loc * inv).astype(v.dtype), vw)
         + jnp.einsum('bnhgqc,bchd->bnqhgd', (p_ctx * inv).astype(v.dtype), vc))
    return o.reshape(B, S, ATT_WIDTH)


def context_self_attention(qc, kc, vc, sink):
    B, L = qc.shape[:2]
    scale = ATT_HEAD_DIM ** -0.5
    qg = qc.reshape(B, L, ATT_KV_HEADS, ATT_GROUP, ATT_HEAD_DIM)
    s = jnp.einsum('bqhgd,bkhd->bhgqk', qg, kc).astype(jnp.float32) * scale
    sk = sink.astype(jnp.float32).reshape(1, ATT_KV_HEADS, ATT_GROUP, 1, 1)
    m = jnp.maximum(s.max(-1, keepdims=True), sk)
    p = jnp.exp(s - m)
    p = p / (p.sum(-1, keepdims=True) + jnp.exp(sk - m))
    o = jnp.einsum('bhgqk,bkhd->bqhgd', p.astype(vc.dtype), vc)
    return o.reshape(B, L, ATT_WIDTH)


def centred_dwconv(t, w):
    pad = w.shape[0] // 2
    return lax.conv_general_dilated(t, w[:, None, :].astype(t.dtype), window_strides=(1,),
                                    padding=[(pad, pad)], dimension_numbers=('NWC', 'WIO', 'NWC'),
                                    feature_group_count=t.shape[-1])


def mlstm_heads(t, d):
    B, T = t.shape[:2]
    return t.reshape(B, T, ML_HEADS, d).transpose(0, 2, 1, 3).astype(jnp.float32)


def mlstm_prepare(mq, mk, mv, mg, w_conv, gate_bias):
    qk = jax.nn.silu(centred_dwconv(jnp.concatenate([mq, mk], axis=-1), w_conv))
    mq, mk = jnp.split(qk, 2, axis=-1)
    B, T = mq.shape[:2]
    g = (mg.astype(jnp.float32) + gate_bias.astype(jnp.float32)).reshape(B, T, 4, ML_HEADS).transpose(0, 3, 1, 2)
    return mlstm_heads(mq, ML_QK_DIM), mlstm_heads(mk, ML_QK_DIM), mlstm_heads(mv, ML_V_DIM), g


def mlstm_zero_state(B):
    return (jnp.zeros((B, ML_HEADS, ML_V_DIM, ML_QK_DIM), jnp.float32),
            jnp.zeros((B, ML_HEADS, ML_QK_DIM), jnp.float32),
            jnp.zeros((B, ML_HEADS), jnp.float32))


def mlstm_chunkwise(q, k, v, ig, lf, state):
    B, H, T, _ = q.shape
    nc = T // ML_CHUNK
    q = q * (ML_QK_DIM ** -0.5)

    def to_chunks(a):
        return jnp.moveaxis(a.reshape(B, H, nc, ML_CHUNK, *a.shape[3:]), 2, 0)

    xs = tuple(to_chunks(a) for a in (q, k, v, ig, lf))
    lower = jnp.tril(jnp.ones((ML_CHUNK, ML_CHUNK), dtype=bool))

    def step(carry, inp):
        C, n, m = carry
        qc, kc, vc, ic, fc = inp
        b = jnp.cumsum(fc, axis=-1)
        a_inter = b + m[..., None]
        d = jnp.where(lower, b[..., :, None] - b[..., None, :] + ic[..., None, :], -jnp.inf)
        m_t = jnp.maximum(a_inter, d.max(-1))
        w_intra = jnp.exp(d - m_t[..., None])
        w_inter = jnp.exp(a_inter - m_t)
        s = jnp.einsum('bhtd,bhsd->bhts', qc, kc) * w_intra
        num = jnp.einsum('bhts,bhsv->bhtv', s, vc) + w_inter[..., None] * jnp.einsum('bhvd,bhtd->bhtv', C, qc)
        den = s.sum(-1) + w_inter * jnp.einsum('bhd,bhtd->bht', n, qc)
        h = num / jnp.maximum(jnp.abs(den), jnp.exp(-m_t))[..., None]
        b_last = b[..., -1]
        g = b_last[..., None] - b + ic
        m_new = jnp.maximum(b_last + m, g.max(-1))
        decay = jnp.exp(b_last + m - m_new)
        wk = jnp.exp(g - m_new[..., None])
        C = decay[..., None, None] * C + jnp.einsum('bhs,bhsv,bhsd->bhvd', wk, vc, kc)
        n = decay[..., None] * n + jnp.einsum('bhs,bhsd->bhd', wk, kc)
        return (C, n, m_new), h

    state, hs = lax.scan(step, state, xs)
    return jnp.moveaxis(hs, 0, 2).reshape(B, H, T, ML_V_DIM), state


def mlstm_bidir(q, k, v, g, state_f, state_b):
    h_f, st_f = mlstm_chunkwise(q, k, v, g[..., 0], jax.nn.log_sigmoid(g[..., 1]), state_f)
    flip = lambda t: jnp.flip(t, axis=2)
    h_b, st_b = mlstm_chunkwise(flip(q), flip(k), flip(v), flip(g[..., 2]),
                                flip(jax.nn.log_sigmoid(g[..., 3])), state_b)
    return h_f + flip(h_b), st_f, st_b


def mlstm_output(h, o_pre, gain):
    B, H, T, DV = h.shape
    hf = h.transpose(0, 2, 1, 3)
    hf = hf * lax.rsqrt(jnp.mean(hf * hf, axis=-1, keepdims=True) + EPS) * gain.astype(jnp.float32).reshape(ML_HEADS, ML_V_DIM)
    return hf.reshape(B, T, ML_WIDTH).astype(o_pre.dtype) * jax.nn.sigmoid(o_pre)


def swiglu(h, w_in, w_out):
    gate, up = jnp.split(h @ w_in, 2, axis=-1)
    return (jax.nn.silu(gate) * up) @ w_out


def setup_inputs(seed: int = 0) -> dict:
    key = jax.random.key(seed)
    ks = jax.random.split(key, 20)
    nrm = lambda k, shape, s: jax.random.normal(k, shape, jnp.float32) * s
    fgt = jnp.linspace(3.0, 6.0, ML_HEADS, dtype=jnp.float32)
    zh = jnp.zeros((ML_HEADS,), jnp.float32)
    gate_base = jnp.concatenate([zh, fgt, zh, fgt])
    return {
        'x': nrm(ks[0], (BATCH, SEQ, D_MODEL), 1.0),
        'c': nrm(ks[1], (BATCH, D_MODEL), 1.0),
        'ctx': nrm(ks[2], (BATCH, CTX_LEN, D_MODEL), 1.0),
        'c_ctx': nrm(ks[3], (D_MODEL,), 1.0),
        'w_ada': nrm(ks[4], (DEPTH, D_MODEL, 6 * D_MODEL), 0.5 * D_MODEL ** -0.5),
        'b_ada': nrm(ks[5], (DEPTH, 6 * D_MODEL), 0.02),
        'g_pre_mix': 1.0 + nrm(ks[6], (DEPTH, D_MODEL), 0.05),
        'w_in': nrm(ks[7], (DEPTH, D_MODEL, IN_WIDTH), D_MODEL ** -0.5),
        'w_conv_qk': nrm(ks[8], (DEPTH, ML_CONV, 2 * ML_QK_WIDTH), ML_CONV ** -0.5),
        'b_gates': gate_base[None, :] + nrm(ks[9], (DEPTH, ML_GATES), 0.1),
        'attn_sink': nrm(ks[10], (DEPTH, ATT_HEADS), 0.5),
        'g_mlstm_out': 1.0 + nrm(ks[11], (DEPTH, ML_WIDTH), 0.05),
        'w_out': nrm(ks[12], (DEPTH, MIX_WIDTH, D_MODEL), MIX_WIDTH ** -0.5),
        'g_post_mix': 1.0 + nrm(ks[13], (DEPTH, D_MODEL), 0.05),
        'g_pre_ffn': 1.0 + nrm(ks[14], (DEPTH, D_MODEL), 0.05),
        'w_ffn_in': nrm(ks[15], (DEPTH, D_MODEL, 2 * FFN_HIDDEN), D_MODEL ** -0.5),
        'w_ffn_out': nrm(ks[16], (DEPTH, FFN_HIDDEN, D_MODEL), FFN_HIDDEN ** -0.5),
        'g_post_ffn': 1.0 + nrm(ks[17], (DEPTH, D_MODEL), 0.05),
    }


def reference(x, c, ctx, c_ctx, w_ada, b_ada, g_pre_mix, w_in, w_conv_qk, b_gates, attn_sink,
              g_mlstm_out, w_out, g_post_mix, g_pre_ffn, w_ffn_in, w_ffn_out, g_post_ffn):
    B, S, _ = x.shape
    L = ctx.shape[1]
    rope = axial_rope_tables(S, x.dtype)
    silu_c = jax.nn.silu(c)
    silu_cc = jax.nn.silu(c_ctx)
    for layer in range(DEPTH):
        advance_ctx = layer + 1 < DEPTH
        mod_x = (silu_c @ w_ada[layer] + b_ada[layer])[:, None, :]
        mod_c = silu_cc @ w_ada[layer] + b_ada[layer]
        sh_m, sc_m, gt_m, sh_f, sc_f, gt_f = jnp.split(mod_x, 6, axis=-1)
        csh_m, csc_m, cgt_m, csh_f, csc_f, cgt_f = jnp.split(mod_c, 6, axis=-1)

        px = modulate(rms_norm(x, g_pre_mix[layer]), sh_m, sc_m) @ w_in[layer]
        pc = modulate(rms_norm(ctx, g_pre_mix[layer]), csh_m, csc_m) @ w_in[layer]
        aqx, akx, avx, mqx, mkx, mvx, mox, mgx = jnp.split(px, SPLIT_AT, axis=-1)
        aqc, akc, avc, mqc, mkc, mvc, moc, mgc = jnp.split(pc, SPLIT_AT, axis=-1)

        kc_att = akc.reshape(B, L, ATT_KV_HEADS, ATT_HEAD_DIM)
        vc_att = avc.reshape(B, L, ATT_KV_HEADS, ATT_HEAD_DIM)
        qx_att = axial_rope(aqx.reshape(B, S, ATT_HEADS, ATT_HEAD_DIM), *rope)
        kx_att = axial_rope(akx.reshape(B, S, ATT_KV_HEADS, ATT_HEAD_DIM), *rope)
        att_x = window_attention(qx_att, kx_att, avx.reshape(B, S, ATT_KV_HEADS, ATT_HEAD_DIM),
                                 kc_att, vc_att, attn_sink[layer])

        cq, ck, cv, cg = mlstm_prepare(mqc, mkc, mvc, mgc, w_conv_qk[layer], b_gates[layer])
        h_ml_c, st_f, st_b = mlstm_bidir(cq, ck, cv, cg, mlstm_zero_state(B), mlstm_zero_state(B))
        xq, xk, xv, xg = mlstm_prepare(mqx, mkx, mvx, mgx, w_conv_qk[layer], b_gates[layer])
        h_ml_x, _, _ = mlstm_bidir(xq, xk, xv, xg, st_f, st_b)
        ml_x = mlstm_output(h_ml_x, mox, g_mlstm_out[layer])

        mix_x = jnp.concatenate([att_x, ml_x], axis=-1) @ w_out[layer]
        x = x + gt_m * rms_norm(mix_x, g_post_mix[layer])
        if advance_ctx:
            att_c = context_self_attention(aqc.reshape(B, L, ATT_HEADS, ATT_HEAD_DIM), kc_att, vc_att, attn_sink[layer])
            ml_c = mlstm_output(h_ml_c, moc, g_mlstm_out[layer])
            mix_c = jnp.concatenate([att_c, ml_c], axis=-1) @ w_out[layer]
            ctx = ctx + cgt_m * rms_norm(mix_c, g_post_mix[layer])

        fx = swiglu(modulate(rms_norm(x, g_pre_ffn[layer]), sh_f, sc_f), w_ffn_in[layer], w_ffn_out[layer])
        x = x + gt_f * rms_norm(fx, g_post_ffn[layer])
        if advance_ctx:
            fc = swiglu(modulate(rms_norm(ctx, g_pre_ffn[layer]), csh_f, csc_f), w_ffn_in[layer], w_ffn_out[layer])
            ctx = ctx + cgt_f * rms_norm(fc, g_post_ffn[layer])
    return x
```

```cpp
#include <hip/hip_runtime.h>
#include <hip/hip_cooperative_groups.h>
#include <cstdio>
#include <cstdint>
namespace cg = cooperative_groups;
namespace pg8 {
#define PG8_LAS __attribute__((address_space(3)))
typedef unsigned short bf16_t;
typedef short bf16x8 __attribute__((ext_vector_type(8)));
typedef float f32x4 __attribute__((ext_vector_type(4)));
typedef unsigned u32x4 __attribute__((ext_vector_type(4)));
constexpr int BM = 256, BK = 64, HALF = 128, HTB = HALF * BK * 2  , STAGE_BYTES = 8 * HTB, NXCD = 8, WGM = 8;

__host__ __device__ __forceinline__ int lds_byte(int r, int c) { const int st = (r >> 4) * 2 + (c >> 5), rr = r & 15, cc = c & 31, ob = rr * 64 + cc * 2; return st * 1024 + (ob ^ (((ob >> 9) & 1) << 5)); }
__host__ __device__ __forceinline__ void stage_rc(int b, int& R, int& C) { const int st = b / 1024, sb = b % 1024, swz = sb ^ (((sb >> 9) & 1) << 5); R = (st >> 1) * 16 + swz / 64; C = (st & 1) * 32 + (swz % 64) / 2; }
__host__ __device__ __forceinline__ int perm32(int rho) { const int n = rho >> 4, i = rho & 15; return 8 * (i >> 2) + 4 * n + (i & 3); }

struct Unit { int pm, pn; };
struct Gemm { const bf16_t* A; const bf16_t* Bt; int M, N, K; };

struct StaticOrder {
    int nM, nN, nwg, G, c;
    __host__ __device__ void init(int M, int N, int G_, int c_) { nM = M / BM; nN = N / BM; nwg = nM * nN; G = G_; c = c_; }
    __host__ __device__ bool next(int i, Unit& u) const {
        const long L = (long)i * G + c; if (L >= nwg) return false;
        int wgid = (int)L; { const int q = nwg / NXCD, r = nwg % NXCD, xcd = wgid % NXCD, off = wgid / NXCD; wgid = (xcd < r ? xcd * (q + 1) : r * (q + 1) + (xcd - r) * q) + off; }
        const int nig = WGM * nN, gid = wgid / nig, fm = gid * WGM, gsz = (nM - fm) < WGM ? (nM - fm) : WGM;
        u.pm = fm + ((wgid % nig) % gsz); u.pn = (wgid % nig) / gsz; return true;
    }
    __device__ __forceinline__ void a_ready(const Unit&) const {}
    __device__ __forceinline__ void done(const Unit&) const {}
};

__device__ __forceinline__ unsigned cvt_pk_bf16(float lo, float hi) { unsigned r; asm volatile("v_cvt_pk_bf16_f32 %0, %1, %2" : "=v"(r) : "v"(lo), "v"(hi)); return r; }
struct EpiBf16 {
    static constexpr bool PERM = true, AFTER_DRAIN = false;
    bf16_t* O; int ldc;
    __device__ __forceinline__ void operator()(const f32x4 (&acc)[2][2][4][2], const Unit& u, int wr, int wc, int fr, int fq) const {
        const int row0 = u.pm * BM + wr * 64 + fr; const int col0 = u.pn * BM + wc * 32 + 8 * fq;
#pragma unroll
        for (int ai = 0; ai < 2; ++ai)
#pragma unroll
            for (int m = 0; m < 4; ++m) { bf16_t* rowp = O + (size_t)(row0 + ai * HALF + m * 16) * ldc + col0;
#pragma unroll
                for (int bj = 0; bj < 2; ++bj) { const f32x4 v0 = acc[ai][bj][m][0], v1 = acc[ai][bj][m][1];
                    u32x4 w; w.x = cvt_pk_bf16(v0[0], v0[1]); w.y = cvt_pk_bf16(v0[2], v0[3]); w.z = cvt_pk_bf16(v1[0], v1[1]); w.w = cvt_pk_bf16(v1[2], v1[3]);
                    *(u32x4*)(rowp + bj * HALF) = w; } }
    }
};
__device__ __forceinline__ float silu_f(float g) { return g * __builtin_amdgcn_rcpf(1.0f + __builtin_amdgcn_exp2f(-1.44269504089f * g)); }
struct EpiSwiglu {
    static constexpr bool PERM = true, AFTER_DRAIN = false;
    bf16_t* O; int ldc;
    __device__ __forceinline__ void operator()(const f32x4 (&acc)[2][2][4][2], const Unit& u, int wr, int wc, int fr, int fq) const {
        const int row0 = u.pm * BM + wr * 64 + fr; const int col0 = u.pn * HALF + wc * 32 + 8 * fq;
#pragma unroll
        for (int ai = 0; ai < 2; ++ai)
#pragma unroll
            for (int m = 0; m < 4; ++m) { bf16_t* rowp = O + (size_t)(row0 + ai * HALF + m * 16) * ldc + col0;
                const f32x4 g0 = acc[ai][0][m][0], g1 = acc[ai][0][m][1], u0 = acc[ai][1][m][0], u1 = acc[ai][1][m][1];
                u32x4 w; w.x = cvt_pk_bf16(silu_f(g0[0]) * u0[0], silu_f(g0[1]) * u0[1]); w.y = cvt_pk_bf16(silu_f(g0[2]) * u0[2], silu_f(g0[3]) * u0[3]);
                w.z = cvt_pk_bf16(silu_f(g1[0]) * u1[0], silu_f(g1[1]) * u1[1]); w.w = cvt_pk_bf16(silu_f(g1[2]) * u1[2], silu_f(g1[3]) * u1[3]);
                *(u32x4*)rowp = w; }
    }
};
template <class Epi, class Sched, bool ALIGN_EPI = false, bool SP2 = false>
__device__ __forceinline__ void gemm_phase(PG8_LAS unsigned char* lds, const Gemm g, const Sched& S, const Epi& E) {
    const int tid = threadIdx.x, wid = __builtin_amdgcn_readfirstlane(tid >> 6), lane = tid & 63, wr = wid >> 2, wc = wid & 3, fr = lane & 15, fq = lane >> 4;
    const int K = g.K, nt = K / BK;
    unsigned voffA[2], voffB[2];
#pragma unroll
    for (int i = 0; i < 2; ++i) { int R, C; stage_rc(tid * 16 + i * 8192, R, C); const int Rb = Epi::PERM ? ((R & ~31) + perm32(R & 31)) : R;
        voffA[i] = (unsigned)(R * K + C) * 2u; voffB[i] = (unsigned)(Rb * K + C) * 2u; }
    const size_t kstep = (size_t)(BK * 2);
    const size_t hstep = (size_t)HALF * K * 2;
    const size_t tstep = 2 * hstep;
    const unsigned ldsw = (unsigned)wid * 1024u;
    const int aoff = lds_byte(wr * 64 + fr, fq * 8), boff = lds_byte(wc * 32 + fr, fq * 8);
#define PG8_SA(b, h) (((b) * 2 + (h)) * HTB)
#define PG8_SB(b, h) ((4 + (b) * 2 + (h)) * HTB)
#define PG8_STAGE(bufoff, gbase, voff) do { _Pragma("unroll") for (int _i = 0; _i < 2; ++_i) \
        __builtin_amdgcn_global_load_lds((const unsigned*)((const char*)(gbase) + (voff)[_i]), (PG8_LAS unsigned*)(lds + (bufoff) + ldsw + _i * 8192), 16, 0, 0); } while (0)
#define PG8_LDA(dst, b, h) do { _Pragma("unroll") for (int m = 0; m < 4; ++m) _Pragma("unroll") for (int k = 0; k < 2; ++k) dst[m][k] = *(const PG8_LAS bf16x8*)(lds + PG8_SA(b, h) + aoff + m * 2048 + k * 1024); } while (0)
#define PG8_LDB(dst, b, h) do { _Pragma("unroll") for (int n = 0; n < 2; ++n) _Pragma("unroll") for (int k = 0; k < 2; ++k) dst[n][k] = *(const PG8_LAS bf16x8*)(lds + PG8_SB(b, h) + boff + n * 2048 + k * 1024); } while (0)
#define PG8_MMA(ai, bj, At, Bt) do { __builtin_amdgcn_s_setprio(1); _Pragma("unroll") for (int m = 0; m < 4; ++m) _Pragma("unroll") for (int n = 0; n < 2; ++n) _Pragma("unroll") for (int k = 0; k < 2; ++k) \
        acc[ai][bj][m][n] = __builtin_amdgcn_mfma_f32_16x16x32_bf16(Bt[n][k], At[m][k], acc[ai][bj][m][n], 0, 0, 0); __builtin_amdgcn_s_setprio(0); } while (0)
#define PG8_WAIT_V(n) asm volatile("s_waitcnt vmcnt(" #n ")" ::: "memory")
#define PG8_WAIT_L(n) asm volatile("s_waitcnt lgkmcnt(" #n ")" ::: "memory")
#define PG8_BAR __builtin_amdgcn_s_barrier()
#define PG8_SCHED __builtin_amdgcn_sched_barrier(0)
    Unit cur, nxt; int ui = 0;
    if (!S.next(0, cur)) return;
    f32x4 acc[2][2][4][2];
#pragma unroll
    for (int a = 0; a < 2; ++a)
#pragma unroll
        for (int b = 0; b < 2; ++b)
#pragma unroll
            for (int m = 0; m < 4; ++m)
#pragma unroll
                for (int n = 0; n < 2; ++n) acc[a][b][m][n] = (f32x4){0.f, 0.f, 0.f, 0.f};
    bf16x8 At[4][2], B0[2][2], B1[2][2];
    const char* cA = (const char*)g.A + (size_t)cur.pm * tstep; const char* cB = (const char*)g.Bt + (size_t)cur.pn * tstep;
    S.a_ready(cur);
    if constexpr (SP2) {
        PG8_STAGE(PG8_SB(0, 0), cB, voffB); PG8_STAGE(PG8_SB(0, 1), cB + hstep, voffB); PG8_STAGE(PG8_SA(0, 0), cA, voffA); PG8_STAGE(PG8_SA(0, 1), cA + hstep, voffA);
        if (wr == 1) PG8_BAR;
        PG8_WAIT_V(2); PG8_BAR;
        PG8_STAGE(PG8_SB(1, 0), cB + kstep, voffB); PG8_STAGE(PG8_SA(1, 0), cA + kstep, voffA); PG8_STAGE(PG8_SB(1, 1), cB + hstep + kstep, voffB);
        PG8_WAIT_V(6); PG8_BAR;
    } else {
        PG8_STAGE(PG8_SB(0, 0), cB, voffB); PG8_STAGE(PG8_SA(0, 0), cA, voffA); PG8_STAGE(PG8_SB(0, 1), cB + hstep, voffB); PG8_STAGE(PG8_SA(0, 1), cA + hstep, voffA);
        if (wr == 1) PG8_BAR;
        PG8_WAIT_V(4); PG8_BAR;
        PG8_STAGE(PG8_SB(1, 0), cB + kstep, voffB); PG8_STAGE(PG8_SA(1, 0), cA + kstep, voffA); PG8_STAGE(PG8_SB(1, 1), cB + hstep + kstep, voffB);
        PG8_WAIT_V(6); PG8_BAR;
    }
    for (;;) {
        const bool has_next = S.next(ui + 1, nxt);
        const char* nA = has_next ? (const char*)g.A + (size_t)nxt.pm * tstep : cA; const char* nB = has_next ? (const char*)g.Bt + (size_t)nxt.pn * tstep : cB;
        for (int t = 0; t < nt; t += 2) {
            const bool last = (t == nt - 2);
            const char* a1 = cA + (size_t)(t + 1) * kstep;
            const char* a2 = last ? nA : cA + (size_t)(t + 2) * kstep; const char* b2 = last ? nB : cB + (size_t)(t + 2) * kstep;
            const char* a3 = a2 + kstep; const char* b3 = b2 + kstep;
            if (last && has_next) S.a_ready(nxt);
            if constexpr (SP2) {
            PG8_LDB(B0, 0, 0); PG8_LDB(B1, 0, 1); PG8_SCHED; PG8_LDA(At, 0, 0); PG8_STAGE(PG8_SA(1, 1), a1 + hstep, voffA);
            PG8_WAIT_V(8); PG8_WAIT_L(0); PG8_BAR; PG8_MMA(0, 0, At, B0); PG8_MMA(0, 1, At, B1); PG8_BAR; PG8_SCHED;
            PG8_LDA(At, 0, 1); PG8_STAGE(PG8_SB(0, 0), b2, voffB); PG8_STAGE(PG8_SB(0, 1), b2 + hstep, voffB); PG8_STAGE(PG8_SA(0, 0), a2, voffA);
            PG8_WAIT_V(8); PG8_WAIT_L(0); PG8_BAR; PG8_MMA(1, 0, At, B0); PG8_MMA(1, 1, At, B1); PG8_BAR; PG8_SCHED;
            PG8_LDB(B0, 1, 0); PG8_LDB(B1, 1, 1); PG8_SCHED; PG8_LDA(At, 1, 0); PG8_STAGE(PG8_SA(0, 1), a2 + hstep, voffA);
            PG8_WAIT_V(8); PG8_WAIT_L(0); PG8_BAR; PG8_MMA(0, 0, At, B0); PG8_MMA(0, 1, At, B1); PG8_BAR; PG8_SCHED;
            PG8_LDA(At, 1, 1); PG8_STAGE(PG8_SB(1, 0), b3, voffB); PG8_STAGE(PG8_SB(1, 1), b3 + hstep, voffB); PG8_STAGE(PG8_SA(1, 0), a3, voffA);
            PG8_WAIT_V(8); PG8_WAIT_L(0); PG8_BAR; PG8_MMA(1, 0, At, B0); PG8_MMA(1, 1, At, B1); PG8_BAR; PG8_SCHED;
            } else {
            PG8_LDB(B0, 0, 0); PG8_SCHED; PG8_LDA(At, 0, 0); PG8_STAGE(PG8_SA(1, 1), a1 + hstep, voffA);
            PG8_WAIT_L(8); PG8_BAR; PG8_WAIT_L(0); PG8_MMA(0, 0, At, B0); PG8_BAR; PG8_SCHED;
            PG8_LDB(B1, 0, 1); PG8_STAGE(PG8_SB(0, 0), b2, voffB);
            PG8_BAR; PG8_WAIT_L(0); PG8_MMA(0, 1, At, B1); PG8_BAR;
            PG8_LDA(At, 0, 1); PG8_STAGE(PG8_SA(0, 0), a2, voffA);
            PG8_BAR; PG8_WAIT_L(0); PG8_MMA(1, 0, At, B0); PG8_BAR; PG8_SCHED;
            PG8_STAGE(PG8_SB(0, 1), b2 + hstep, voffB);
            PG8_WAIT_V(6); PG8_BAR; PG8_MMA(1, 1, At, B1); PG8_BAR;
            PG8_LDB(B0, 1, 0); PG8_SCHED; PG8_LDA(At, 1, 0); PG8_STAGE(PG8_SA(0, 1), a2 + hstep, voffA);
            PG8_WAIT_L(8); PG8_BAR; PG8_WAIT_L(0); PG8_MMA(0, 0, At, B0); PG8_BAR; PG8_SCHED;
            PG8_LDB(B1, 1, 1); PG8_STAGE(PG8_SB(1, 0), b3, voffB);
            PG8_BAR; PG8_WAIT_L(0); PG8_MMA(0, 1, At, B1); PG8_BAR;
            PG8_LDA(At, 1, 1); PG8_STAGE(PG8_SA(1, 0), a3, voffA);
            PG8_BAR; PG8_WAIT_L(0); PG8_MMA(1, 0, At, B0); PG8_BAR; PG8_SCHED;
            PG8_STAGE(PG8_SB(1, 1), b3 + hstep, voffB);
            PG8_WAIT_V(6); PG8_BAR; PG8_MMA(1, 1, At, B1); PG8_BAR;
            }
        }
        if constexpr (ALIGN_EPI) { if (wr == 0) PG8_BAR; }
        if constexpr (!Epi::AFTER_DRAIN) { E(acc, cur, wr, wc, fr, fq); S.done(cur); }
        if (!has_next) break;
#pragma unroll
        for (int a = 0; a < 2; ++a)
#pragma unroll
            for (int b = 0; b < 2; ++b)
#pragma unroll
                for (int m = 0; m < 4; ++m)
#pragma unroll
                    for (int n = 0; n < 2; ++n) acc[a][b][m][n] = (f32x4){0.f, 0.f, 0.f, 0.f};
        cur = nxt; cA = nA; cB = nB; ++ui;
        if constexpr (ALIGN_EPI) { if (wr == 1) PG8_BAR; }
    }
    PG8_WAIT_V(0);
    if constexpr (!ALIGN_EPI) { if (wr == 0) PG8_BAR; }
    PG8_BAR;
    if constexpr (Epi::AFTER_DRAIN) { E.fused(acc, cur, wr, wc, fr, fq, lds, wid, lane); S.done(cur); }
#undef PG8_SA
#undef PG8_SB
#undef PG8_STAGE
#undef PG8_LDA
#undef PG8_LDB
#undef PG8_MMA
#undef PG8_WAIT_V
#undef PG8_WAIT_L
#undef PG8_BAR
#undef PG8_SCHED
}
}

#define LAS __attribute__((address_space(3)))
typedef unsigned short bf16;
typedef float f32x4 __attribute__((ext_vector_type(4)));
typedef float f32x2 __attribute__((ext_vector_type(2)));
typedef short bf16x8 __attribute__((ext_vector_type(8)));
typedef unsigned u32x4 __attribute__((ext_vector_type(4)));
typedef unsigned u32x2 __attribute__((ext_vector_type(2)));
constexpr int NWAVES = 8, NTHR = 512;
constexpr int D = 1024, NB = 8, SEQ = 2048, CTXL = 256, MX = NB * SEQ, MC = NB * CTXL, MT = MX + MC;
constexpr int NIN = 2304, INW = 2320, FF = 2816;
constexpr int C_AQ = 0, C_AK = 512, C_AV = 640, C_MQ = 768, C_MK = 1024, C_MV = 1280, C_MO = 1792;
constexpr int NCH = 36;
constexpr int STSZ = 8256;
constexpr float EPSF = 1e-6f;
constexpr size_t MiB = 1u << 20;
constexpr size_t WS_MOD = 1 * MiB;
constexpr size_t WS_ROPE = 1 * MiB + 512 * 1024;
constexpr size_t WS_WIN = 2 * MiB, WS_WOUT = 7 * MiB, WS_WFI = 9 * MiB, WS_WFO = 20 * MiB;
constexpr size_t WS_GATES = 26 * MiB;
constexpr size_t WS_SCAL = 28 * MiB;
constexpr size_t WS_A = 30 * MiB;
constexpr size_t WS_PX = 66 * MiB;
constexpr size_t WS_QKS = 147 * MiB;
constexpr size_t WS_ST = 165 * MiB;
constexpr size_t WS_MIX = 66 * MiB;
constexpr size_t WS_H = 100 * MiB;
constexpr size_t WS_FX = 190 * MiB;
constexpr int LDS_BYTES = 139264;

struct Args {
    const float *x, *c, *ctx, *c_ctx, *w_ada, *b_ada, *g_pre_mix, *w_in, *w_conv, *b_gates, *sink, *g_ml, *w_out, *g_post_mix, *g_pre_ffn, *w_ffi, *w_ffo, *g_post_ffn;
    float* out; unsigned char* ws; int ph_lo, ph_hi;
};

__device__ __forceinline__ unsigned f2bf(float f) { unsigned u = __builtin_bit_cast(unsigned, f); return (u + 0x7fffu + ((u >> 16) & 1u)) >> 16; }
__device__ __forceinline__ unsigned pk2(float lo, float hi) { return f2bf(lo) | (f2bf(hi) << 16); }
__device__ __forceinline__ float bf2f(unsigned h) { return __builtin_bit_cast(float, h << 16); }
__device__ __forceinline__ float bflo(unsigned w) { return __builtin_bit_cast(float, w << 16); }
__device__ __forceinline__ float bfhi(unsigned w) { return __builtin_bit_cast(float, w & 0xffff0000u); }
__device__ __forceinline__ float wave_sum(float v) {
#pragma unroll
    for (int o = 1; o < 64; o <<= 1) v += __shfl_xor(v, o);
    return v;
}
__device__ __forceinline__ float wave_max(float v) {
#pragma unroll
    for (int o = 1; o < 64; o <<= 1) v = fmaxf(v, __shfl_xor(v, o));
    return v;
}
__device__ __forceinline__ float red16_sum(float v) { v += __shfl_xor(v, 1); v += __shfl_xor(v, 2); v += __shfl_xor(v, 4); v += __shfl_xor(v, 8); return v; }
__device__ __forceinline__ float red16_max(float v) { v = fmaxf(v, __shfl_xor(v, 1)); v = fmaxf(v, __shfl_xor(v, 2)); v = fmaxf(v, __shfl_xor(v, 4)); v = fmaxf(v, __shfl_xor(v, 8)); return v; }
__device__ __forceinline__ float logsig(float f) { return fminf(f, 0.f) - log1pf(expf(-fabsf(f))); }
__device__ __forceinline__ f32x4 mfma16(bf16x8 a, bf16x8 b, f32x4 c) { return __builtin_amdgcn_mfma_f32_16x16x32_bf16(a, b, c, 0, 0, 0); }
#define LDS_WAIT() asm volatile("s_waitcnt lgkmcnt(0)" ::: "memory")

__device__ __forceinline__ void transpose_item(const float* W, int ldw, int K, bf16* WT, int dst_row0, int k0, int n0, LAS float* scr, int lane) {
#pragma unroll 8
    for (int i = 0; i < 32; ++i) { const int kk = 2 * i + (lane >> 5); scr[kk * 33 + (lane & 31)] = W[(size_t)(k0 + kk) * ldw + n0 + (lane & 31)]; }
    LDS_WAIT(); asm volatile("" ::: "memory");
    const int c = lane & 7;
#pragma unroll
    for (int j = 0; j < 4; ++j) { const int n = (lane >> 3) + 8 * j; const LAS float* s = scr + (8 * c) * 33 + n;
        u32x4 o; o.x = pk2(s[0 * 33], s[1 * 33]); o.y = pk2(s[2 * 33], s[3 * 33]); o.z = pk2(s[4 * 33], s[5 * 33]); o.w = pk2(s[6 * 33], s[7 * 33]);
        *(u32x4*)(WT + (size_t)(dst_row0 + n) * K + k0 + 8 * c) = o; }
    LDS_WAIT(); asm volatile("" ::: "memory");
}

__device__ __forceinline__ void phase0(const Args& a, LAS unsigned char* lds, int tid, int lane, int wave, int G) {
    unsigned char* ws = a.ws;
    float* mod = (float*)(ws + WS_MOD);
    { float* rope = (float*)(ws + WS_ROPE);
      for (int i = blockIdx.x * NTHR + tid; i < 96 * 16; i += G * NTHR) { const int pos = i >> 4, f = i & 15; const float inv = powf(10000.0f, -(float)f / 16.0f);
          const float ang = (float)(pos < 32 ? pos : pos - 32) * inv; rope[2 * i] = cosf(ang); rope[2 * i + 1] = sinf(ang); } }
    for (int it = G - 1 - (int)blockIdx.x; it < 96; it += G) {
        LAS float* sv = (LAS float*)lds;
        LAS float* red = (LAS float*)(lds + 40960);
        for (int i = tid; i < 9 * 1024; i += NTHR) { const int r = i >> 10, k = i & 1023; const float cv = r < 8 ? a.c[r * 1024 + k] : a.c_ctx[k]; sv[i] = cv / (1.0f + expf(-cv)); }
        __syncthreads();
        const int cq = tid & 15, kg = tid >> 4, j0 = it * 64;
        f32x4 acc[9];
#pragma unroll
        for (int r = 0; r < 9; ++r) acc[r] = (f32x4){0.f, 0.f, 0.f, 0.f};
#pragma unroll 4
        for (int kk = 0; kk < 32; ++kk) { const int k = kg * 32 + kk; const f32x4 w = *(const f32x4*)(a.w_ada + (size_t)k * 6144 + j0 + cq * 4);
#pragma unroll
            for (int r = 0; r < 9; ++r) acc[r] += sv[r * 1024 + k] * w; }
#pragma unroll
        for (int r = 0; r < 9; ++r)
#pragma unroll
            for (int e = 0; e < 4; ++e) { float v = acc[r][e]; v += __shfl_xor(v, 16); v += __shfl_xor(v, 32); acc[r][e] = v; }
        if (lane < 16) {
#pragma unroll
            for (int r = 0; r < 9; ++r)
#pragma unroll
                for (int e = 0; e < 4; ++e) red[(wave * 9 + r) * 64 + cq * 4 + e] = acc[r][e];
        }
        __syncthreads();
        for (int i = tid; i < 9 * 64; i += NTHR) { const int r = i >> 6, col = i & 63; float s = a.b_ada[j0 + col];
#pragma unroll
            for (int w = 0; w < 8; ++w) s += red[(w * 9 + r) * 64 + col];
            mod[r * 6144 + j0 + col] = s; }
        __syncthreads();
    }
    LAS float* scr = (LAS float*)(lds + wave * 8448);
    const int gw = blockIdx.x * NWAVES + wave, NGW = G * NWAVES;
    constexpr int I_IN = 16 * 72, I_OUT = 16 * 32, I_FI = 16 * 176, I_FO = 44 * 32;
    for (int it = gw; it < I_IN + I_OUT + I_FI + I_FO; it += NGW) {
        int r = it;
        if (r < I_IN) { const int kb = r / 72, nb = r % 72; transpose_item(a.w_in, INW, D, (bf16*)(ws + WS_WIN), 32 * nb, 64 * kb, 32 * nb, scr, lane); continue; } r -= I_IN;
        if (r < I_OUT) { const int kb = r / 32, nb = r % 32; transpose_item(a.w_out, D, D, (bf16*)(ws + WS_WOUT), 32 * nb, 64 * kb, 32 * nb, scr, lane); continue; } r -= I_OUT;
        if (r < I_FI) { const int kb = r / 176, nb = r % 176; const int n0 = 32 * nb, bj = n0 >= FF ? 1 : 0, jj = n0 - bj * FF; const int dst = 256 * (jj >> 7) + 128 * bj + (jj & 127);
            transpose_item(a.w_ffi, 2 * FF, D, (bf16*)(ws + WS_WFI), dst, 64 * kb, n0, scr, lane); continue; } r -= I_FI;
        { const int kb = r / 32, nb = r % 32; transpose_item(a.w_ffo, D, FF, (bf16*)(ws + WS_WFO), 32 * nb, 64 * kb, 32 * nb, scr, lane); }
    }
}

__device__ __forceinline__ void phase1(const Args& a, LAS unsigned char* lds, int tid, int lane, int wave, int G) {
    unsigned char* ws = a.ws; const float* mod = (const float*)(ws + WS_MOD);
    bf16* A = (bf16*)(ws + WS_A); float* gates = (float*)(ws + WS_GATES);
    LAS f32x4* WgL = (LAS f32x4*)lds;
    for (int i = tid; i < 16384; i += NTHR) { const int k = i >> 4, j = i & 15; const int kpos = ((k >> 8) * 4 + (k & 3)) * 64 + ((k >> 2) & 63);
        ((LAS float*)lds)[((j >> 2) * 1024 + kpos) * 4 + (j & 3)] = a.w_in[(size_t)k * INW + NIN + j]; }
    __syncthreads();
    const int gw = blockIdx.x * NWAVES + wave, NGW = G * NWAVES;
    for (int row = gw; row < MT; row += NGW) {
        const float* xr = row < MX ? a.x + (size_t)row * D : a.ctx + (size_t)(row - MX) * D;
        const float* mrow = mod + (row < MX ? (row >> 11) : 8) * 6144;
        f32x4 v[4]; float ss = 0.f;
#pragma unroll
        for (int j = 0; j < 4; ++j) { v[j] = ((const f32x4*)xr)[lane + 64 * j]; ss += (v[j].x * v[j].x + v[j].y * v[j].y) + (v[j].z * v[j].z + v[j].w * v[j].w); }
        const float rstd = rsqrtf(wave_sum(ss) * (1.0f / D) + EPSF);
#pragma unroll
        for (int j = 0; j < 4; ++j) { const int k = 4 * lane + 256 * j;
            const f32x4 g = *(const f32x4*)(a.g_pre_mix + k), sh = *(const f32x4*)(mrow + k), sc = *(const f32x4*)(mrow + 1024 + k);
            v[j] = (v[j] * rstd * g) * (1.0f + sc) + sh;
            u32x2 o; o.x = pk2(v[j].x, v[j].y); o.y = pk2(v[j].z, v[j].w);
            *(u32x2*)(A + (size_t)row * D + k) = o; }
        float ga[16];
#pragma unroll
        for (int q = 0; q < 16; ++q) ga[q] = 0.f;
#pragma unroll
        for (int j = 0; j < 4; ++j)
#pragma unroll
            for (int c = 0; c < 4; ++c) { const int kpos = (j * 4 + c) * 64 + lane; const float av = v[j][c];
#pragma unroll
                for (int jq = 0; jq < 4; ++jq) { const f32x4 w = WgL[jq * 1024 + kpos]; ga[jq * 4 + 0] += av * w.x; ga[jq * 4 + 1] += av * w.y; ga[jq * 4 + 2] += av * w.z; ga[jq * 4 + 3] += av * w.w; }
                if (c & 1) __builtin_amdgcn_sched_barrier(0); }
        float mine = 0.f;
#pragma unroll
        for (int q = 0; q < 16; ++q) { const float s = wave_sum(ga[q]); if (lane == q) mine = s; }
        if (lane < 16) gates[(size_t)row * 16 + lane] = mine;
    }
}

__device__ __forceinline__ void attn_unit(const Args& a, LAS unsigned char* lds, int unit, int tid, int lane, int wave) {
    unsigned char* ws = a.ws; const bf16* px = (const bf16*)(ws + WS_PX); const float* rope = (const float*)(ws + WS_ROPE); bf16* mixcat = (bf16*)(ws + WS_A);
    const int hp = unit & 1, qb = (unit >> 1) & 15, hk = (unit >> 5) & 1, b = unit >> 6;
    LAS bf16* Qs = (LAS bf16*)lds;
    LAS bf16* Ks = (LAS bf16*)(lds + 36864);
    LAS bf16* VT = (LAS bf16*)(lds + 46080);
    LAS bf16* Pw = (LAS bf16*)(lds + 55296) + wave * (32 * 72);
    const int fr = lane & 15, fq = lane >> 4;
    __syncthreads();
#pragma unroll
    for (int tt = 0; tt < 2; ++tt) { const int task = tid + tt * NTHR; const int r = task >> 2, part = task & 3, half = part >> 1, sub = (part & 1) * 8;
        const int pos = qb * 128 + (r & 127), head = hk * 4 + hp * 2 + (r >> 7);
        const bf16* src = px + (size_t)(b * SEQ + pos) * NIN + C_AQ + head * 64 + half * 32 + sub;
        const u32x4 w1 = *(const u32x4*)src, w2 = *(const u32x4*)(src + 16);
        const float* tb = rope + ((half == 0 ? (pos >> 6) : 32 + (pos & 63)) * 16 + sub) * 2;
        u32x4 o1, o2;
#pragma unroll
        for (int i = 0; i < 4; ++i) { const f32x4 cs = *(const f32x4*)(tb + 4 * i);
            const float u1a = bflo(w1[i]), u1b = bfhi(w1[i]), u2a = bflo(w2[i]), u2b = bfhi(w2[i]);
            o1[i] = pk2(u1a * cs.x - u2a * cs.y, u1b * cs.z - u2b * cs.w); o2[i] = pk2(u2a * cs.x + u1a * cs.y, u2b * cs.z + u1b * cs.w); }
        *(LAS u32x4*)(Qs + r * 72 + half * 32 + sub) = o1; *(LAS u32x4*)(Qs + r * 72 + half * 32 + 16 + sub) = o2; }
    __syncthreads();
    bf16x8 qf[2][2];
#pragma unroll
    for (int rt = 0; rt < 2; ++rt)
#pragma unroll
        for (int kk = 0; kk < 2; ++kk) qf[rt][kk] = *(const LAS bf16x8*)(Qs + (wave * 32 + rt * 16 + fr) * 72 + kk * 32 + fq * 8);
    const int head = hk * 4 + hp * 2 + (wave >> 2);
    const float sinkv = a.sink[head];
    float mrun[2][4], lrun[2][4]; f32x4 O[2][4];
#pragma unroll
    for (int rt = 0; rt < 2; ++rt) {
#pragma unroll
        for (int j = 0; j < 4; ++j) { mrun[rt][j] = sinkv; lrun[rt][j] = (fr == 0) ? 1.0f : 0.0f; }
#pragma unroll
        for (int dt = 0; dt < 4; ++dt) O[rt][dt] = (f32x4){0.f, 0.f, 0.f, 0.f}; }
    const int qbase = qb * 128 + (wave & 3) * 32;
    for (int tile = 0; tile < 10; ++tile) {
        const bool lat = tile < 6; const int kt = qb * 2 - 2 + tile;
        if (lat && (kt < 0 || kt >= 32)) continue;
        const int key0 = lat ? kt * 64 : 0;
        const size_t krow0 = lat ? (size_t)(b * SEQ + key0) : (size_t)(MX + b * CTXL + (tile - 6) * 64);
        __syncthreads();
        if (lat) {
            if (tid < 256) { const int key = tid >> 2, part = tid & 3, half = part >> 1, sub = (part & 1) * 8; const int pos = key0 + key;
                const bf16* src = px + (krow0 + key) * NIN + C_AK + hk * 64 + half * 32 + sub;
                const u32x4 w1 = *(const u32x4*)src, w2 = *(const u32x4*)(src + 16);
                const float* tb = rope + ((half == 0 ? (pos >> 6) : 32 + (pos & 63)) * 16 + sub) * 2;
                u32x4 o1, o2;
#pragma unroll
                for (int i = 0; i < 4; ++i) { const f32x4 cs = *(const f32x4*)(tb + 4 * i);
                    const float u1a = bflo(w1[i]), u1b = bfhi(w1[i]), u2a = bflo(w2[i]), u2b = bfhi(w2[i]);
                    o1[i] = pk2(u1a * cs.x - u2a * cs.y, u1b * cs.z - u2b * cs.w); o2[i] = pk2(u2a * cs.x + u1a * cs.y, u2b * cs.z + u1b * cs.w); }
                *(LAS u32x4*)(Ks + key * 72 + half * 32 + sub) = o1; *(LAS u32x4*)(Ks + key * 72 + half * 32 + 16 + sub) = o2; }
        } else {
            const int key = tid >> 3, ck = tid & 7;
            *(LAS u32x4*)(Ks + key * 72 + ck * 8) = *(const u32x4*)(px + (krow0 + key) * NIN + C_AK + hk * 64 + ck * 8);
        }
        { const int key = tid >> 3, ck = tid & 7; const u32x4 w = *(const u32x4*)(px + (krow0 + key) * NIN + C_AV + hk * 64 + ck * 8);
#pragma unroll
          for (int i = 0; i < 4; ++i) { VT[(ck * 8 + 2 * i) * 72 + key] = (bf16)(w[i] & 0xffffu); VT[(ck * 8 + 2 * i + 1) * 72 + key] = (bf16)(w[i] >> 16); } }
        __syncthreads();
        f32x4 sc[2][4];
#pragma unroll
        for (int rt = 0; rt < 2; ++rt)
#pragma unroll
            for (int kt4 = 0; kt4 < 4; ++kt4) { f32x4 acc = (f32x4){0.f, 0.f, 0.f, 0.f};
#pragma unroll
                for (int kk = 0; kk < 2; ++kk) acc = mfma16(qf[rt][kk], *(const LAS bf16x8*)(Ks + (kt4 * 16 + fr) * 72 + kk * 32 + fq * 8), acc);
                sc[rt][kt4] = acc; }
#pragma unroll
        for (int rt = 0; rt < 2; ++rt)
#pragma unroll
            for (int j = 0; j < 4; ++j) { const int qpos = qbase + rt * 16 + fq * 4 + j; float mx = -INFINITY;
#pragma unroll
                for (int kt4 = 0; kt4 < 4; ++kt4) { float s = sc[rt][kt4][j] * 0.125f; const int dpos = qpos - (key0 + kt4 * 16 + fr);
                    if (lat && (dpos > 128 || dpos < -128)) s = -INFINITY; sc[rt][kt4][j] = s; mx = fmaxf(mx, s); }
                mx = red16_max(mx);
                const float mnew = fmaxf(mrun[rt][j], mx), alpha = __expf(mrun[rt][j] - mnew); mrun[rt][j] = mnew;
                float ps = 0.f;
#pragma unroll
                for (int kt4 = 0; kt4 < 4; ++kt4) { const float p = __expf(sc[rt][kt4][j] - mnew); ps += p; Pw[(rt * 16 + fq * 4 + j) * 72 + kt4 * 16 + fr] = (bf16)f2bf(p); }
                lrun[rt][j] = lrun[rt][j] * alpha + ps;
#pragma unroll
                for (int dt = 0; dt < 4; ++dt) O[rt][dt][j] *= alpha; }
        LDS_WAIT(); asm volatile("" ::: "memory");
#pragma unroll
        for (int rt = 0; rt < 2; ++rt)
#pragma unroll
            for (int kk = 0; kk < 2; ++kk) { const bf16x8 pa = *(const LAS bf16x8*)(Pw + (rt * 16 + fr) * 72 + kk * 32 + fq * 8);
#pragma unroll
                for (int dt = 0; dt < 4; ++dt) O[rt][dt] = mfma16(pa, *(const LAS bf16x8*)(VT + (dt * 16 + fr) * 72 + kk * 32 + fq * 8), O[rt][dt]); }
    }
#pragma unroll
    for (int rt = 0; rt < 2; ++rt)
#pragma unroll
        for (int j = 0; j < 4; ++j) { const float inv = 1.0f / red16_sum(lrun[rt][j]); const int qpos = qbase + rt * 16 + fq * 4 + j;
            bf16* orow = mixcat + (size_t)(b * SEQ + qpos) * D + head * 64 + fr;
#pragma unroll
            for (int dt = 0; dt < 4; ++dt) orow[dt * 16] = (bf16)f2bf(O[rt][dt][j] * inv); }
}

__device__ __forceinline__ void ml_local_unit(const Args& a, LAS unsigned char* lds, int unit, int tid, int lane, int wave) {
    unsigned char* ws = a.ws; const bf16* px = (const bf16*)(ws + WS_PX); const float* gates = (const float*)(ws + WS_GATES);
    bf16* qks = (bf16*)(ws + WS_QKS); float* scal = (float*)(ws + WS_SCAL); float* st = (float*)(ws + WS_ST);
    const int h = unit & 3, bc = unit >> 2, c36 = bc % NCH, b = bc / NCH;
    const int T = c36 < 4 ? CTXL : SEQ, t0 = c36 < 4 ? c36 * 64 : (c36 - 4) * 64;
    const size_t rowbase = c36 < 4 ? (size_t)(MX + b * CTXL) : (size_t)(b * SEQ);
    LAS float* gl = (LAS float*)lds;
    LAS bf16* KT = (LAS bf16*)(lds + 2048);
    LAS bf16* AV = (LAS bf16*)(lds + 2048 + 9216);
    const int fr = lane & 15, fq = lane >> 4;
    const int bhdF = (b * 4 + h) * 2, bhdB = bhdF + 1;
    __syncthreads();
    if (tid < 64) { const float* g = gates + (rowbase + t0 + tid) * 16;
        gl[tid] = logsig(g[4 + h] + a.b_gates[4 + h]); gl[64 + tid] = logsig(g[12 + h] + a.b_gates[12 + h]);
        gl[128 + tid] = g[h] + a.b_gates[h]; gl[192 + tid] = g[8 + h] + a.b_gates[8 + h]; }
    __syncthreads();
    if (tid < 64) { float sf = 0.f, pb = 0.f, totf = 0.f, totb = 0.f;
        for (int u = 0; u < 64; ++u) { const float lf = gl[u], lb = gl[64 + u]; totf += lf; totb += lb; if (u > tid) sf += lf; if (u < tid) pb += lb; }
        const float gf = sf + gl[128 + tid], gb = pb + gl[192 + tid];
        const float mf = wave_max(gf), mb = wave_max(gb);
        gl[256 + tid] = expf(gf - mf); gl[320 + tid] = expf(gb - mb);
        if (tid == 0) { scal[(bhdF * NCH + c36) * 2] = mf; scal[(bhdF * NCH + c36) * 2 + 1] = totf; scal[(bhdB * NCH + c36) * 2] = mb; scal[(bhdB * NCH + c36) * 2 + 1] = totb; } }
    { const int s = tid >> 3, cg8 = tid & 7, isk = cg8 >> 2, c0 = (cg8 & 3) * 16; const int col = (isk ? C_MK : C_MQ) + h * 64 + c0, wch = isk * 256 + h * 64 + c0; const int t = t0 + s;
      float acc[16];
#pragma unroll
      for (int i = 0; i < 16; ++i) acc[i] = 0.f;
#pragma unroll
      for (int dt = 0; dt < 3; ++dt) { const int tt = t + dt - 1; if (tt >= 0 && tt < T) { const bf16* src = px + (rowbase + tt) * NIN + col; const float* wc = a.w_conv + dt * 512 + wch;
#pragma unroll
          for (int hq = 0; hq < 2; ++hq) { const u32x4 w = *(const u32x4*)(src + 8 * hq);
#pragma unroll
              for (int i = 0; i < 4; ++i) { acc[hq * 8 + 2 * i] += wc[hq * 8 + 2 * i] * bflo(w[i]); acc[hq * 8 + 2 * i + 1] += wc[hq * 8 + 2 * i + 1] * bfhi(w[i]); } } } }
      const float qs = isk ? 1.0f : 0.125f;
#pragma unroll
      for (int i = 0; i < 16; ++i) { const float v = acc[i]; acc[i] = qs * v / (1.0f + expf(-v)); }
      u32x4 o0, o1;
#pragma unroll
      for (int i = 0; i < 4; ++i) { o0[i] = pk2(acc[2 * i], acc[2 * i + 1]); o1[i] = pk2(acc[8 + 2 * i], acc[8 + 2 * i + 1]); }
      bf16* dst = qks + (rowbase + t) * 512 + isk * 256 + h * 64 + c0; *(u32x4*)dst = o0; *(u32x4*)(dst + 8) = o1;
      if (isk) {
#pragma unroll
          for (int i = 0; i < 16; ++i) KT[(c0 + i) * 72 + s] = (bf16)f2bf(acc[i]); } }
    __syncthreads();
    { const int s = tid >> 3, vg = tid & 7; const bf16* src = px + (rowbase + t0 + s) * NIN + C_MV + h * 128 + vg * 16; const float wf = gl[256 + s], wb = gl[320 + s];
#pragma unroll
      for (int hq = 0; hq < 2; ++hq) { const u32x4 w = *(const u32x4*)(src + 8 * hq);
#pragma unroll
          for (int i = 0; i < 4; ++i) { const float v0 = bflo(w[i]), v1 = bfhi(w[i]); const int v = vg * 16 + hq * 8 + 2 * i;
              AV[v * 72 + s] = (bf16)f2bf(v0 * wf); AV[(v + 1) * 72 + s] = (bf16)f2bf(v1 * wf);
              AV[(128 + v) * 72 + s] = (bf16)f2bf(v0 * wb); AV[(128 + v + 1) * 72 + s] = (bf16)f2bf(v1 * wb); } } }
    __syncthreads();
#pragma unroll
    for (int dir = 0; dir < 2; ++dir) { float* dst = st + ((size_t)((bhdF + dir) * NCH + c36)) * STSZ;
#pragma unroll
        for (int dt = 0; dt < 4; ++dt) { f32x4 acc = (f32x4){0.f, 0.f, 0.f, 0.f};
#pragma unroll
            for (int kk = 0; kk < 2; ++kk) acc = mfma16(*(const LAS bf16x8*)(AV + (dir * 128 + wave * 16 + fr) * 72 + kk * 32 + fq * 8), *(const LAS bf16x8*)(KT + (dt * 16 + fr) * 72 + kk * 32 + fq * 8), acc);
#pragma unroll
            for (int j = 0; j < 4; ++j) dst[(wave * 16 + fq * 4 + j) * 64 + dt * 16 + fr] = acc[j]; } }
    if (tid < 128) { const int dir = tid >> 6, d = tid & 63; float s = 0.f;
        for (int u = 0; u < 64; ++u) s += gl[256 + dir * 64 + u] * bf2f(KT[d * 72 + u]);
        st[((size_t)((bhdF + dir) * NCH + c36)) * STSZ + 8192 + d] = s; }
}

__device__ __forceinline__ void phase4(const Args& a, int tid, int G) {
    unsigned char* ws = a.ws; float* st = (float*)(ws + WS_ST); const float* scal = (const float*)(ws + WS_SCAL); float* mprev = (float*)(ws + WS_SCAL + 65536);
    constexpr int NV = STSZ / 4;
    for (int ch = blockIdx.x * NTHR + tid; ch < 64 * NV; ch += G * NTHR) { const int bhd = ch / NV, e = ch - bhd * NV, dir = bhd & 1;
        float m = 0.f; f32x4 C = (f32x4){0.f, 0.f, 0.f, 0.f};
        for (int s0 = 0; s0 < NCH; s0 += 6) { f32x4 dd[6]; float ml[6], bl[6];
#pragma unroll
            for (int i = 0; i < 6; ++i) { const int step = s0 + i; const int c36 = dir == 0 ? step : (step < 4 ? 3 - step : 39 - step);
                dd[i] = *(const f32x4*)(st + ((size_t)(bhd * NCH + c36)) * STSZ + e * 4); ml[i] = scal[(bhd * NCH + c36) * 2]; bl[i] = scal[(bhd * NCH + c36) * 2 + 1]; }
#pragma unroll
            for (int i = 0; i < 6; ++i) { const int step = s0 + i; const int c36 = dir == 0 ? step : (step < 4 ? 3 - step : 39 - step);
                if (c36 >= 4) { *(f32x4*)(st + ((size_t)(bhd * NCH + c36)) * STSZ + e * 4) = C; if (e == 0) mprev[bhd * NCH + c36] = m; }
                const float mn = fmaxf(bl[i] + m, ml[i]); const float dec = expf(bl[i] + m - mn), sc = expf(ml[i] - mn);
                C = dec * C + sc * dd[i]; m = mn; } } }
}

__device__ __forceinline__ void ml_out_unit(const Args& a, LAS unsigned char* lds, int unit, int tid, int lane, int wave) {
    unsigned char* ws = a.ws; const bf16* px = (const bf16*)(ws + WS_PX); const float* gates = (const float*)(ws + WS_GATES);
    const bf16* qks = (const bf16*)(ws + WS_QKS); const float* st = (const float*)(ws + WS_ST); const float* mprev = (const float*)(ws + WS_SCAL + 65536); bf16* mixcat = (bf16*)(ws + WS_A);
    const int h = unit & 3, bc = unit >> 2, c = bc & 31, b = bc >> 5, c36 = c + 4;
    const size_t row0 = (size_t)(b * SEQ + c * 64);
    const int bhdF = (b * 4 + h) * 2;
    const float* stF = st + ((size_t)(bhdF * NCH + c36)) * STSZ; const float* stB = st + ((size_t)((bhdF + 1) * NCH + c36)) * STSZ;
    LAS float* gl = (LAS float*)lds;
    LAS bf16* Qs = (LAS bf16*)(lds + 8192);
    LAS bf16* Ks = (LAS bf16*)(lds + 8192 + 9216);
    LAS bf16* VT = (LAS bf16*)(lds + 8192 + 18432);
    LAS bf16* CF = (LAS bf16*)(lds + 8192 + 36864);
    LAS bf16* CB = (LAS bf16*)(lds + 8192 + 55296);
    LAS bf16* SF = (LAS bf16*)(lds + 8192 + 73728);
    LAS bf16* SB = (LAS bf16*)(lds + 8192 + 82944);
    enum { LFF = 0, LFB = 64, IGF = 128, IGB = 192, ROWF = 256, ROWB = 320, CCF = 384, CCB = 448, WIF = 512, WIB = 576, LOWF = 640, LOWB = 704, NF = 768, NBK = 832, QNF = 896, QNB = 960, RSP = 1024, SSQ = 1536 };
    const int fr = lane & 15, fq = lane >> 4;
    __syncthreads();
    if (tid < 64) { const float* g = gates + (row0 + tid) * 16;
        gl[LFF + tid] = logsig(g[4 + h] + a.b_gates[4 + h]); gl[LFB + tid] = logsig(g[12 + h] + a.b_gates[12 + h]);
        gl[IGF + tid] = g[h] + a.b_gates[h]; gl[IGB + tid] = g[8 + h] + a.b_gates[8 + h]; }
    else if (tid < 192) { const int dir = (tid - 64) >> 6, d = tid & 63; gl[NF + dir * 64 + d] = (dir ? stB : stF)[8192 + d]; }
    { const int s = tid >> 3, ck = tid & 7; const bf16* src = qks + (row0 + s) * 512 + h * 64 + ck * 8;
      *(LAS u32x4*)(Qs + s * 72 + ck * 8) = *(const u32x4*)src; *(LAS u32x4*)(Ks + s * 72 + ck * 8) = *(const u32x4*)(src + 256);
      const bf16* vs = px + (row0 + s) * NIN + C_MV + h * 128 + ck * 16;
#pragma unroll
      for (int hq = 0; hq < 2; ++hq) { const u32x4 w = *(const u32x4*)(vs + 8 * hq);
#pragma unroll
          for (int i = 0; i < 4; ++i) { const int v = ck * 16 + hq * 8 + 2 * i; VT[v * 72 + s] = (bf16)(w[i] & 0xffffu); VT[(v + 1) * 72 + s] = (bf16)(w[i] >> 16); } } }
    { const int v = tid >> 2, dq = tid & 3;
#pragma unroll
      for (int dir = 0; dir < 2; ++dir) { const float* src = (dir ? stB : stF) + v * 64 + dq * 16; LAS bf16* dst = (dir ? CB : CF) + v * 72 + dq * 16;
          const f32x4 x0 = *(const f32x4*)src, x1 = *(const f32x4*)(src + 4), x2 = *(const f32x4*)(src + 8), x3 = *(const f32x4*)(src + 12);
          u32x4 o0, o1; o0.x = pk2(x0.x, x0.y); o0.y = pk2(x0.z, x0.w); o0.z = pk2(x1.x, x1.y); o0.w = pk2(x1.z, x1.w); o1.x = pk2(x2.x, x2.y); o1.y = pk2(x2.z, x2.w); o1.z = pk2(x3.x, x3.y); o1.w = pk2(x3.z, x3.w);
          *(LAS u32x4*)dst = o0; *(LAS u32x4*)(dst + 8) = o1; } }
    __syncthreads();
    if (tid < 64) { const int t = tid; const float mpF = mprev[bhdF * NCH + c36], mpB = mprev[(bhdF + 1) * NCH + c36];
        { float run = 0.f, pmax = -INFINITY, bt = 0.f, ct = 0.f;
          for (int u = 0; u < 64; ++u) { run += gl[LFF + u]; const float cu = gl[IGF + u] - run; if (u <= t) pmax = fmaxf(pmax, cu); if (u == t) { bt = run; ct = cu; } }
          const float mt = bt + fmaxf(mpF, pmax); gl[ROWF + t] = bt - mt; gl[CCF + t] = ct; gl[WIF + t] = expf(bt + mpF - mt); gl[LOWF + t] = expf(-mt); }
        { float run = 0.f, pmax = -INFINITY, bt = 0.f, ct = 0.f;
          for (int u = 63; u >= 0; --u) { run += gl[LFB + u]; const float cu = gl[IGB + u] - run; if (u >= t) pmax = fmaxf(pmax, cu); if (u == t) { bt = run; ct = cu; } }
          const float mt = bt + fmaxf(mpB, pmax); gl[ROWB + t] = bt - mt; gl[CCB + t] = ct; gl[WIB + t] = expf(bt + mpB - mt); gl[LOWB + t] = expf(-mt); } }
    else if (tid >= 128 && tid < 256) { const int dir = (tid - 128) >> 6, t = tid & 63; float s = 0.f;
        for (int d = 0; d < 64; ++d) s += bf2f(Qs[t * 72 + d]) * gl[NF + dir * 64 + d];
        gl[QNF + dir * 64 + t] = s; }
    __syncthreads();
    { const int tt = wave & 3;
#pragma unroll
      for (int q = 0; q < 2; ++q) { const int stl = (wave >> 2) * 2 + q; f32x4 acc = (f32x4){0.f, 0.f, 0.f, 0.f};
#pragma unroll
          for (int kk = 0; kk < 2; ++kk) acc = mfma16(*(const LAS bf16x8*)(Qs + (tt * 16 + fr) * 72 + kk * 32 + fq * 8), *(const LAS bf16x8*)(Ks + (stl * 16 + fr) * 72 + kk * 32 + fq * 8), acc);
          const int s = stl * 16 + fr; const float cf = gl[CCF + s], cb = gl[CCB + s];
#pragma unroll
          for (int j = 0; j < 4; ++j) { const int t = tt * 16 + fq * 4 + j;
              const float wF = (s <= t) ? expf(gl[ROWF + t] + cf) : 0.f, wB = (s >= t) ? expf(gl[ROWB + t] + cb) : 0.f;
              const float sf = acc[j] * wF, sb = acc[j] * wB;
              SF[t * 72 + s] = (bf16)f2bf(sf); SB[t * 72 + s] = (bf16)f2bf(sb);
              const float rf = red16_sum(sf), rb = red16_sum(sb);
              if (fr == 0) { gl[RSP + t * 4 + stl] = rf; gl[RSP + 256 + t * 4 + stl] = rb; } } } }
    __syncthreads();
    { const int tt = wave & 3, vh = wave >> 2;
      f32x4 aS[2][4], aI[2][4];
#pragma unroll
      for (int dir = 0; dir < 2; ++dir)
#pragma unroll
          for (int vt = 0; vt < 4; ++vt) { aS[dir][vt] = (f32x4){0.f, 0.f, 0.f, 0.f}; aI[dir][vt] = (f32x4){0.f, 0.f, 0.f, 0.f}; }
#pragma unroll
      for (int kk = 0; kk < 2; ++kk) { const bf16x8 qa = *(const LAS bf16x8*)(Qs + (tt * 16 + fr) * 72 + kk * 32 + fq * 8);
          const bf16x8 sfa = *(const LAS bf16x8*)(SF + (tt * 16 + fr) * 72 + kk * 32 + fq * 8), sba = *(const LAS bf16x8*)(SB + (tt * 16 + fr) * 72 + kk * 32 + fq * 8);
#pragma unroll
          for (int vt = 0; vt < 4; ++vt) { const int vrow = (vh * 64 + vt * 16 + fr) * 72 + kk * 32 + fq * 8;
              const bf16x8 vb = *(const LAS bf16x8*)(VT + vrow);
              aS[0][vt] = mfma16(sfa, vb, aS[0][vt]); aS[1][vt] = mfma16(sba, vb, aS[1][vt]);
              aI[0][vt] = mfma16(qa, *(const LAS bf16x8*)(CF + vrow), aI[0][vt]); aI[1][vt] = mfma16(qa, *(const LAS bf16x8*)(CB + vrow), aI[1][vt]); } }
      float hv[4][4];
#pragma unroll
      for (int j = 0; j < 4; ++j) { const int t = tt * 16 + fq * 4 + j;
          const float wiF = gl[WIF + t], wiB = gl[WIB + t];
          const float denF = (gl[RSP + t * 4] + gl[RSP + t * 4 + 1]) + (gl[RSP + t * 4 + 2] + gl[RSP + t * 4 + 3]) + wiF * gl[QNF + t];
          const float denB = (gl[RSP + 256 + t * 4] + gl[RSP + 256 + t * 4 + 1]) + (gl[RSP + 256 + t * 4 + 2] + gl[RSP + 256 + t * 4 + 3]) + wiB * gl[QNB + t];
          const float iF = 1.0f / fmaxf(fabsf(denF), gl[LOWF + t]), iB = 1.0f / fmaxf(fabsf(denB), gl[LOWB + t]);
          float ss = 0.f;
#pragma unroll
          for (int vt = 0; vt < 4; ++vt) { const float hval = (aS[0][vt][j] + wiF * aI[0][vt][j]) * iF + (aS[1][vt][j] + wiB * aI[1][vt][j]) * iB; hv[vt][j] = hval; ss += hval * hval; }
          ss = red16_sum(ss);
          if (fr == 0) gl[SSQ + t * 2 + vh] = ss; }
      __syncthreads();
#pragma unroll
      for (int j = 0; j < 4; ++j) { const int t = tt * 16 + fq * 4 + j; const float rms = rsqrtf((gl[SSQ + t * 2] + gl[SSQ + t * 2 + 1]) * (1.0f / 128.0f) + EPSF);
          const bf16* mo = px + (row0 + t) * NIN + C_MO + h * 128 + vh * 64 + fr; bf16* orow = mixcat + (row0 + t) * D + 512 + h * 128 + vh * 64 + fr;
#pragma unroll
          for (int vt = 0; vt < 4; ++vt) { const float o = bf2f(mo[vt * 16]); const float y = hv[vt][j] * rms * a.g_ml[h * 128 + vh * 64 + vt * 16 + fr];
              orow[vt * 16] = (bf16)f2bf(y / (1.0f + expf(-o))); } } }
}

__device__ __forceinline__ void phase7(const Args& a, int lane, int wave, int G) {
    unsigned char* ws = a.ws; const float* mod = (const float*)(ws + WS_MOD); const bf16* mix = (const bf16*)(ws + WS_MIX); bf16* A = (bf16*)(ws + WS_A);
    const int gw = blockIdx.x * NWAVES + wave, NGW = G * NWAVES;
    for (int row = gw; row < MX; row += NGW) { const float* mrow = mod + (row >> 11) * 6144;
        f32x4 v[4]; float ss = 0.f;
#pragma unroll
        for (int j = 0; j < 4; ++j) { const u32x2 w = *(const u32x2*)(mix + (size_t)row * D + 4 * lane + 256 * j); v[j] = (f32x4){bflo(w.x), bfhi(w.x), bflo(w.y), bfhi(w.y)};
            ss += (v[j].x * v[j].x + v[j].y * v[j].y) + (v[j].z * v[j].z + v[j].w * v[j].w); }
        const float rstd = rsqrtf(wave_sum(ss) * (1.0f / D) + EPSF);
        float s2 = 0.f;
#pragma unroll
        for (int j = 0; j < 4; ++j) { const int k = 4 * lane + 256 * j; const f32x4 xv = *(const f32x4*)(a.x + (size_t)row * D + k);
            const f32x4 g = *(const f32x4*)(a.g_post_mix + k), gt = *(const f32x4*)(mrow + 2048 + k);
            v[j] = xv + gt * ((v[j] * rstd) * g); *(f32x4*)(a.out + (size_t)row * D + k) = v[j];
            s2 += (v[j].x * v[j].x + v[j].y * v[j].y) + (v[j].z * v[j].z + v[j].w * v[j].w); }
        const float rstd2 = rsqrtf(wave_sum(s2) * (1.0f / D) + EPSF);
#pragma unroll
        for (int j = 0; j < 4; ++j) { const int k = 4 * lane + 256 * j; const f32x4 g = *(const f32x4*)(a.g_pre_ffn + k), sh = *(const f32x4*)(mrow + 3072 + k), sc = *(const f32x4*)(mrow + 4096 + k);
            const f32x4 y = ((v[j] * rstd2) * g) * (1.0f + sc) + sh; u32x2 o; o.x = pk2(y.x, y.y); o.y = pk2(y.z, y.w); *(u32x2*)(A + (size_t)row * D + k) = o; } }
}
__device__ __forceinline__ void phase10(const Args& a, int lane, int wave, int G) {
    unsigned char* ws = a.ws; const float* mod = (const float*)(ws + WS_MOD); const bf16* fx = (const bf16*)(ws + WS_FX);
    const int gw = blockIdx.x * NWAVES + wave, NGW = G * NWAVES;
    for (int row = gw; row < MX; row += NGW) { const float* mrow = mod + (row >> 11) * 6144;
        f32x4 v[4]; float ss = 0.f;
#pragma unroll
        for (int j = 0; j < 4; ++j) { const u32x2 w = *(const u32x2*)(fx + (size_t)row * D + 4 * lane + 256 * j); v[j] = (f32x4){bflo(w.x), bfhi(w.x), bflo(w.y), bfhi(w.y)};
            ss += (v[j].x * v[j].x + v[j].y * v[j].y) + (v[j].z * v[j].z + v[j].w * v[j].w); }
        const float rstd = rsqrtf(wave_sum(ss) * (1.0f / D) + EPSF);
#pragma unroll
        for (int j = 0; j < 4; ++j) { const int k = 4 * lane + 256 * j; float* op = a.out + (size_t)row * D + k; const f32x4 xv = *(const f32x4*)op;
            const f32x4 g = *(const f32x4*)(a.g_post_ffn + k), gt = *(const f32x4*)(mrow + 5120 + k);
            *(f32x4*)op = xv + gt * ((v[j] * rstd) * g); } }
}

__global__ void __launch_bounds__(NTHR, 2) fwd_kernel(Args a) {
    extern __shared__ __attribute__((aligned(16))) unsigned char lds_raw[];
    LAS unsigned char* lds = (LAS unsigned char*)lds_raw;
    cg::grid_group grid = cg::this_grid();
    const int tid = threadIdx.x, lane = tid & 63, wave = __builtin_amdgcn_readfirstlane(tid >> 6), G = gridDim.x;
    const int lo = a.ph_lo, hi = a.ph_hi;
    unsigned char* ws = a.ws;
#ifndef PHASE_MASK
#define PHASE_MASK 0x7ff
#endif
#define IN(k) (((PHASE_MASK >> (k)) & 1) && lo <= (k) && (k) < hi)
#define SEAM(k) do { if (IN(k) && IN((k) + 1)) { __threadfence(); grid.sync(); } } while (0)
    if (IN(0)) { phase0(a, lds, tid, lane, wave, G); } SEAM(0);
    if (IN(1)) { phase1(a, lds, tid, lane, wave, G); } SEAM(1);
    if (IN(2)) { __syncthreads(); pg8::Gemm g{(const pg8::bf16_t*)(ws + WS_A), (const pg8::bf16_t*)(ws + WS_WIN), MT, NIN, D}; pg8::StaticOrder S; S.init(MT, NIN, G, (int)blockIdx.x);
        pg8::EpiBf16 E{(pg8::bf16_t*)(ws + WS_PX), NIN}; pg8::gemm_phase<pg8::EpiBf16, pg8::StaticOrder, true, true>(lds, g, S, E); } SEAM(2);
    if (IN(3)) { for (int u = blockIdx.x; u < 512; u += G) attn_unit(a, lds, u, tid, lane, wave);
        for (int u = blockIdx.x; u < NB * NCH * 4; u += G) ml_local_unit(a, lds, u, tid, lane, wave); } SEAM(3);
    if (IN(4)) { phase4(a, tid, G); } SEAM(4);
    if (IN(5)) { for (int u = blockIdx.x; u < NB * 32 * 4; u += G) ml_out_unit(a, lds, u, tid, lane, wave); } SEAM(5);
    if (IN(6)) { __syncthreads(); pg8::Gemm g{(const pg8::bf16_t*)(ws + WS_A), (const pg8::bf16_t*)(ws + WS_WOUT), MX, D, D}; pg8::StaticOrder S; S.init(MX, D, G, (int)blockIdx.x);
        pg8::EpiBf16 E{(pg8::bf16_t*)(ws + WS_MIX), D}; pg8::gemm_phase<pg8::EpiBf16, pg8::StaticOrder, true, true>(lds, g, S, E); } SEAM(6);
    if (IN(7)) { phase7(a, lane, wave, G); } SEAM(7);
    if (IN(8)) { __syncthreads(); pg8::Gemm g{(const pg8::bf16_t*)(ws + WS_A), (const pg8::bf16_t*)(ws + WS_WFI), MX, 2 * FF, D}; pg8::StaticOrder S; S.init(MX, 2 * FF, G, (int)blockIdx.x);
        pg8::EpiSwiglu E{(pg8::bf16_t*)(ws + WS_H), FF}; pg8::gemm_phase<pg8::EpiSwiglu, pg8::StaticOrder, true, true>(lds, g, S, E); } SEAM(8);
    if (IN(9)) { __syncthreads(); pg8::Gemm g{(const pg8::bf16_t*)(ws + WS_H), (const pg8::bf16_t*)(ws + WS_WFO), MX, D, FF}; pg8::StaticOrder S; S.init(MX, D, G, (int)blockIdx.x);
        pg8::EpiBf16 E{(pg8::bf16_t*)(ws + WS_FX), D}; pg8::gemm_phase<pg8::EpiBf16, pg8::StaticOrder, true, true>(lds, g, S, E); } SEAM(9);
    if (IN(10)) { phase10(a, lane, wave, G); }
#undef IN
#undef SEAM
}

#ifndef N_LAUNCH_MODE
#define N_LAUNCH_MODE 0
#endif
extern "C" void kernel_launch(void* const* d_in, const int* in_sizes, int n_in, void* d_out, int out_size, void* d_ws, size_t ws_size, hipStream_t stream) {
    static int grid = 0;
    if (grid == 0) {
        int dev = 0, cus = 0, per_cu = 0;
        hipGetDevice(&dev); hipDeviceGetAttribute(&cus, hipDeviceAttributeMultiprocessorCount, dev);
        if (hipFuncSetAttribute((const void*)fwd_kernel, hipFuncAttributeMaxDynamicSharedMemorySize, LDS_BYTES) != hipSuccess) { fprintf(stderr, "kernel_launch: hipFuncSetAttribute failed\n"); grid = -1; return; }
        if (hipOccupancyMaxActiveBlocksPerMultiprocessor(&per_cu, (const void*)fwd_kernel, NTHR, LDS_BYTES) != hipSuccess || per_cu < 1) { fprintf(stderr, "kernel_launch: occupancy query says %d\n", per_cu); per_cu = 1; }
        (void)hipGetLastError();
        grid = cus * 1;
        if (grid <= 0) grid = 256;
    }
    if (grid < 0) return;
    Args a{};
    const float** ap = (const float**)&a;
    for (int i = 0; i < 18; ++i) ap[i] = (const float*)d_in[i];
    a.out = (float*)d_out; a.ws = (unsigned char*)d_ws;
#if N_LAUNCH_MODE == 1
    a.ph_lo = 0; a.ph_hi = 11;
    { void* args[] = {&a}; hipError_t e = hipLaunchCooperativeKernel((const void*)fwd_kernel, dim3(grid), dim3(NTHR), args, LDS_BYTES, stream);
      if (e != hipSuccess) fprintf(stderr, "cooperative launch failed: %s (grid %d)\n", hipGetErrorString(e), grid); }
#else
    for (int p = 0; p < 11; ++p) { a.ph_lo = p; a.ph_hi = p + 1; void* args[] = {&a};
        hipError_t e = hipLaunchCooperativeKernel((const void*)fwd_kernel, dim3(grid), dim3(NTHR), args, LDS_BYTES, stream);
        if (e != hipSuccess) { fprintf(stderr, "launch %d failed: %s (grid %d)\n", p, hipGetErrorString(e), grid); break; } }
#endif
}
```

```cpp
#include <hip/hip_runtime.h>
#include <hip/hip_cooperative_groups.h>
#include <cstdio>
#include <cstdint>
namespace cg = cooperative_groups;
namespace pg8 {
#define PG8_LAS __attribute__((address_space(3)))
typedef unsigned short bf16_t;
typedef short bf16x8 __attribute__((ext_vector_type(8)));
typedef float f32x4 __attribute__((ext_vector_type(4)));
typedef unsigned u32x4 __attribute__((ext_vector_type(4)));
constexpr int BM = 256, BK = 64, HALF = 128, HTB = HALF * BK * 2  , STAGE_BYTES = 8 * HTB, NXCD = 8, WGM = 8;

__host__ __device__ __forceinline__ int lds_byte(int r, int c) { const int st = (r >> 4) * 2 + (c >> 5), rr = r & 15, cc = c & 31, ob = rr * 64 + cc * 2; return st * 1024 + (ob ^ (((ob >> 9) & 1) << 5)); }
__host__ __device__ __forceinline__ void stage_rc(int b, int& R, int& C) { const int st = b / 1024, sb = b % 1024, swz = sb ^ (((sb >> 9) & 1) << 5); R = (st >> 1) * 16 + swz / 64; C = (st & 1) * 32 + (swz % 64) / 2; }
__host__ __device__ __forceinline__ int perm32(int rho) { const int n = rho >> 4, i = rho & 15; return 8 * (i >> 2) + 4 * n + (i & 3); }

struct Unit { int pm, pn; };
struct Gemm { const bf16_t* A; const bf16_t* Bt; int M, N, K; };

struct StaticOrder {
    int nM, nN, nwg, G, c;
    __host__ __device__ void init(int M, int N, int G_, int c_) { nM = M / BM; nN = N / BM; nwg = nM * nN; G = G_; c = c_; }
    __host__ __device__ bool next(int i, Unit& u) const {
        const long L = (long)i * G + c; if (L >= nwg) return false;
        int wgid = (int)L; { const int q = nwg / NXCD, r = nwg % NXCD, xcd = wgid % NXCD, off = wgid / NXCD; wgid = (xcd < r ? xcd * (q + 1) : r * (q + 1) + (xcd - r) * q) + off; }
        const int nig = WGM * nN, gid = wgid / nig, fm = gid * WGM, gsz = (nM - fm) < WGM ? (nM - fm) : WGM;
        u.pm = fm + ((wgid % nig) % gsz); u.pn = (wgid % nig) / gsz; return true;
    }
    __device__ __forceinline__ void a_ready(const Unit&) const {}
    __device__ __forceinline__ void done(const Unit&) const {}
};

__device__ __forceinline__ unsigned cvt_pk_bf16(float lo, float hi) { unsigned r; asm volatile("v_cvt_pk_bf16_f32 %0, %1, %2" : "=v"(r) : "v"(lo), "v"(hi)); return r; }
struct EpiBf16 {
    static constexpr bool PERM = true, AFTER_DRAIN = false;
    bf16_t* O; int ldc;
    __device__ __forceinline__ void operator()(const f32x4 (&acc)[2][2][4][2], const Unit& u, int wr, int wc, int fr, int fq) const {
        const int row0 = u.pm * BM + wr * 64 + fr; const int col0 = u.pn * BM + wc * 32 + 8 * fq;
#pragma unroll
        for (int ai = 0; ai < 2; ++ai)
#pragma unroll
            for (int m = 0; m < 4; ++m) { bf16_t* rowp = O + (size_t)(row0 + ai * HALF + m * 16) * ldc + col0;
#pragma unroll
                for (int bj = 0; bj < 2; ++bj) { const f32x4 v0 = acc[ai][bj][m][0], v1 = acc[ai][bj][m][1];
                    u32x4 w; w.x = cvt_pk_bf16(v0[0], v0[1]); w.y = cvt_pk_bf16(v0[2], v0[3]); w.z = cvt_pk_bf16(v1[0], v1[1]); w.w = cvt_pk_bf16(v1[2], v1[3]);
                    *(u32x4*)(rowp + bj * HALF) = w; } }
    }
};
__device__ __forceinline__ float silu_f(float g) { return g * __builtin_amdgcn_rcpf(1.0f + __builtin_amdgcn_exp2f(-1.44269504089f * g)); }
struct EpiSwiglu {
    static constexpr bool PERM = true, AFTER_DRAIN = false;
    bf16_t* O; int ldc;
    __device__ __forceinline__ void operator()(const f32x4 (&acc)[2][2][4][2], const Unit& u, int wr, int wc, int fr, int fq) const {
        const int row0 = u.pm * BM + wr * 64 + fr; const int col0 = u.pn * HALF + wc * 32 + 8 * fq;
#pragma unroll
        for (int ai = 0; ai < 2; ++ai)
#pragma unroll
            for (int m = 0; m < 4; ++m) { bf16_t* rowp = O + (size_t)(row0 + ai * HALF + m * 16) * ldc + col0;
                const f32x4 g0 = acc[ai][0][m][0], g1 = acc[ai][0][m][1], u0 = acc[ai][1][m][0], u1 = acc[ai][1][m][1];
                u32x4 w; w.x = cvt_pk_bf16(silu_f(g0[0]) * u0[0], silu_f(g0[1]) * u0[1]); w.y = cvt_pk_bf16(silu_f(g0[2]) * u0[2], silu_f(g0[3]) * u0[3]);
                w.z = cvt_pk_bf16(silu_f(g1[0]) * u1[0], silu_f(g1[1]) * u1[1]); w.w = cvt_pk_bf16(silu_f(g1[2]) * u1[2], silu_f(g1[3]) * u1[3]);
                *(u32x4*)rowp = w; }
    }
};
template <class Epi, class Sched, bool ALIGN_EPI = false, bool SP2 = false>
__device__ __forceinline__ void gemm_phase(PG8_LAS unsigned char* lds, const Gemm g, const Sched& S, const Epi& E) {
    const int tid = threadIdx.x, wid = __builtin_amdgcn_readfirstlane(tid >> 6), lane = tid & 63, wr = wid >> 2, wc = wid & 3, fr = lane & 15, fq = lane >> 4;
    const int K = g.K, nt = K / BK;
    unsigned voffA[2], voffB[2];
#pragma unroll
    for (int i = 0; i < 2; ++i) { int R, C; stage_rc(tid * 16 + i * 8192, R, C); const int Rb = Epi::PERM ? ((R & ~31) + perm32(R & 31)) : R;
        voffA[i] = (unsigned)(R * K + C) * 2u; voffB[i] = (unsigned)(Rb * K + C) * 2u; }
    const size_t kstep = (size_t)(BK * 2);
    const size_t hstep = (size_t)HALF * K * 2;
    const size_t tstep = 2 * hstep;
    const unsigned ldsw = (unsigned)wid * 1024u;
    const int aoff = lds_byte(wr * 64 + fr, fq * 8), boff = lds_byte(wc * 32 + fr, fq * 8);
#define PG8_SA(b, h) (((b) * 2 + (h)) * HTB)
#define PG8_SB(b, h) ((4 + (b) * 2 + (h)) * HTB)
#define PG8_STAGE(bufoff, gbase, voff) do { _Pragma("unroll") for (int _i = 0; _i < 2; ++_i) \
        __builtin_amdgcn_global_load_lds((const unsigned*)((const char*)(gbase) + (voff)[_i]), (PG8_LAS unsigned*)(lds + (bufoff) + ldsw + _i * 8192), 16, 0, 0); } while (0)
#define PG8_LDA(dst, b, h) do { _Pragma("unroll") for (int m = 0; m < 4; ++m) _Pragma("unroll") for (int k = 0; k < 2; ++k) dst[m][k] = *(const PG8_LAS bf16x8*)(lds + PG8_SA(b, h) + aoff + m * 2048 + k * 1024); } while (0)
#define PG8_LDB(dst, b, h) do { _Pragma("unroll") for (int n = 0; n < 2; ++n) _Pragma("unroll") for (int k = 0; k < 2; ++k) dst[n][k] = *(const PG8_LAS bf16x8*)(lds + PG8_SB(b, h) + boff + n * 2048 + k * 1024); } while (0)
#define PG8_MMA(ai, bj, At, Bt) do { __builtin_amdgcn_s_setprio(1); _Pragma("unroll") for (int m = 0; m < 4; ++m) _Pragma("unroll") for (int n = 0; n < 2; ++n) _Pragma("unroll") for (int k = 0; k < 2; ++k) \
        acc[ai][bj][m][n] = __builtin_amdgcn_mfma_f32_16x16x32_bf16(Bt[n][k], At[m][k], acc[ai][bj][m][n], 0, 0, 0); __builtin_amdgcn_s_setprio(0); } while (0)
#define PG8_WAIT_V(n) asm volatile("s_waitcnt vmcnt(" #n ")" ::: "memory")
#define PG8_WAIT_L(n) asm volatile("s_waitcnt lgkmcnt(" #n ")" ::: "memory")
#define PG8_BAR __builtin_amdgcn_s_barrier()
#define PG8_SCHED __builtin_amdgcn_sched_barrier(0)
    Unit cur, nxt; int ui = 0;
    if (!S.next(0, cur)) return;
    f32x4 acc[2][2][4][2];
#pragma unroll
    for (int a = 0; a < 2; ++a)
#pragma unroll
        for (int b = 0; b < 2; ++b)
#pragma unroll
            for (int m = 0; m < 4; ++m)
#pragma unroll
                for (int n = 0; n < 2; ++n) acc[a][b][m][n] = (f32x4){0.f, 0.f, 0.f, 0.f};
    bf16x8 At[4][2], B0[2][2], B1[2][2];
    const char* cA = (const char*)g.A + (size_t)cur.pm * tstep; const char* cB = (const char*)g.Bt + (size_t)cur.pn * tstep;
    S.a_ready(cur);
    if constexpr (SP2) {
        PG8_STAGE(PG8_SB(0, 0), cB, voffB); PG8_STAGE(PG8_SB(0, 1), cB + hstep, voffB); PG8_STAGE(PG8_SA(0, 0), cA, voffA); PG8_STAGE(PG8_SA(0, 1), cA + hstep, voffA);
        if (wr == 1) PG8_BAR;
        PG8_WAIT_V(2); PG8_BAR;
        PG8_STAGE(PG8_SB(1, 0), cB + kstep, voffB); PG8_STAGE(PG8_SA(1, 0), cA + kstep, voffA); PG8_STAGE(PG8_SB(1, 1), cB + hstep + kstep, voffB);
        PG8_WAIT_V(6); PG8_BAR;
    } else {
        PG8_STAGE(PG8_SB(0, 0), cB, voffB); PG8_STAGE(PG8_SA(0, 0), cA, voffA); PG8_STAGE(PG8_SB(0, 1), cB + hstep, voffB); PG8_STAGE(PG8_SA(0, 1), cA + hstep, voffA);
        if (wr == 1) PG8_BAR;
        PG8_WAIT_V(4); PG8_BAR;
        PG8_STAGE(PG8_SB(1, 0), cB + kstep, voffB); PG8_STAGE(PG8_SA(1, 0), cA + kstep, voffA); PG8_STAGE(PG8_SB(1, 1), cB + hstep + kstep, voffB);
        PG8_WAIT_V(6); PG8_BAR;
    }
    for (;;) {
        const bool has_next = S.next(ui + 1, nxt);
        const char* nA = has_next ? (const char*)g.A + (size_t)nxt.pm * tstep : cA; const char* nB = has_next ? (const char*)g.Bt + (size_t)nxt.pn * tstep : cB;
        for (int t = 0; t < nt; t += 2) {
            const bool last = (t == nt - 2);
            const char* a1 = cA + (size_t)(t + 1) * kstep;
            const char* a2 = last ? nA : cA + (size_t)(t + 2) * kstep; const char* b2 = last ? nB : cB + (size_t)(t + 2) * kstep;
            const char* a3 = a2 + kstep; const char* b3 = b2 + kstep;
            if (last && has_next) S.a_ready(nxt);
            if constexpr (SP2) {
            PG8_LDB(B0, 0, 0); PG8_LDB(B1, 0, 1); PG8_SCHED; PG8_LDA(At, 0, 0); PG8_STAGE(PG8_SA(1, 1), a1 + hstep, voffA);
            PG8_WAIT_V(8); PG8_WAIT_L(0); PG8_BAR; PG8_MMA(0, 0, At, B0); PG8_MMA(0, 1, At, B1); PG8_BAR; PG8_SCHED;
            PG8_LDA(At, 0, 1); PG8_STAGE(PG8_SB(0, 0), b2, voffB); PG8_STAGE(PG8_SB(0, 1), b2 + hstep, voffB); PG8_STAGE(PG8_SA(0, 0), a2, voffA);
            PG8_WAIT_V(8); PG8_WAIT_L(0); PG8_BAR; PG8_MMA(1, 0, At, B0); PG8_MMA(1, 1, At, B1); PG8_BAR; PG8_SCHED;
            PG8_LDB(B0, 1, 0); PG8_LDB(B1, 1, 1); PG8_SCHED; PG8_LDA(At, 1, 0); PG8_STAGE(PG8_SA(0, 1), a2 + hstep, voffA);
            PG8_WAIT_V(8); PG8_WAIT_L(0); PG8_BAR; PG8_MMA(0, 0, At, B0); PG8_MMA(0, 1, At, B1); PG8_BAR; PG8_SCHED;
            PG8_LDA(At, 1, 1); PG8_STAGE(PG8_SB(1, 0), b3, voffB); PG8_STAGE(PG8_SB(1, 1), b3 + hstep, voffB); PG8_STAGE(PG8_SA(1, 0), a3, voffA);
            PG8_WAIT_V(8); PG8_WAIT_L(0); PG8_BAR; PG8_MMA(1, 0, At, B0); PG8_MMA(1, 1, At, B1); PG8_BAR; PG8_SCHED;
            } else {
            PG8_LDB(B0, 0, 0); PG8_SCHED; PG8_LDA(At, 0, 0); PG8_STAGE(PG8_SA(1, 1), a1 + hstep, voffA);
            PG8_WAIT_L(8); PG8_BAR; PG8_WAIT_L(0); PG8_MMA(0, 0, At, B0); PG8_BAR; PG8_SCHED;
            PG8_LDB(B1, 0, 1); PG8_STAGE(PG8_SB(0, 0), b2, voffB);
            PG8_BAR; PG8_WAIT_L(0); PG8_MMA(0, 1, At, B1); PG8_BAR;
            PG8_LDA(At, 0, 1); PG8_STAGE(PG8_SA(0, 0), a2, voffA);
            PG8_BAR; PG8_WAIT_L(0); PG8_MMA(1, 0, At, B0); PG8_BAR; PG8_SCHED;
            PG8_STAGE(PG8_SB(0, 1), b2 + hstep, voffB);
            PG8_WAIT_V(6); PG8_BAR; PG8_MMA(1, 1, At, B1); PG8_BAR;
            PG8_LDB(B0, 1, 0); PG8_SCHED; PG8_LDA(At, 1, 0); PG8_STAGE(PG8_SA(0, 1), a2 + hstep, voffA);
            PG8_WAIT_L(8); PG8_BAR; PG8_WAIT_L(0); PG8_MMA(0, 0, At, B0); PG8_BAR; PG8_SCHED;
            PG8_LDB(B1, 1, 1); PG8_STAGE(PG8_SB(1, 0), b3, voffB);
            PG8_BAR; PG8_WAIT_L(0); PG8_MMA(0, 1, At, B1); PG8_BAR;
            PG8_LDA(At, 1, 1); PG8_STAGE(PG8_SA(1, 0), a3, voffA);
            PG8_BAR; PG8_WAIT_L(0); PG8_MMA(1, 0, At, B0); PG8_BAR; PG8_SCHED;
            PG8_STAGE(PG8_SB(1, 1), b3 + hstep, voffB);
            PG8_WAIT_V(6); PG8_BAR; PG8_MMA(1, 1, At, B1); PG8_BAR;
            }
        }
        if constexpr (ALIGN_EPI) { if (wr == 0) PG8_BAR; }
        if constexpr (!Epi::AFTER_DRAIN) { E(acc, cur, wr, wc, fr, fq); S.done(cur); }
        if (!has_next) break;
#pragma unroll
        for (int a = 0; a < 2; ++a)
#pragma unroll
            for (int b = 0; b < 2; ++b)
#pragma unroll
                for (int m = 0; m < 4; ++m)
#pragma unroll
                    for (int n = 0; n < 2; ++n) acc[a][b][m][n] = (f32x4){0.f, 0.f, 0.f, 0.f};
        cur = nxt; cA = nA; cB = nB; ++ui;
        if constexpr (ALIGN_EPI) { if (wr == 1) PG8_BAR; }
    }
    PG8_WAIT_V(0);
    if constexpr (!ALIGN_EPI) { if (wr == 0) PG8_BAR; }
    PG8_BAR;
    if constexpr (Epi::AFTER_DRAIN) { E.fused(acc, cur, wr, wc, fr, fq, lds, wid, lane); S.done(cur); }
#undef PG8_SA
#undef PG8_SB
#undef PG8_STAGE
#undef PG8_LDA
#undef PG8_LDB
#undef PG8_MMA
#undef PG8_WAIT_V
#undef PG8_WAIT_L
#undef PG8_BAR
#undef PG8_SCHED
}
}

#define LAS __attribute__((address_space(3)))
typedef unsigned short bf16;
typedef float f32x4 __attribute__((ext_vector_type(4)));
typedef float f32x2 __attribute__((ext_vector_type(2)));
typedef short bf16x8 __attribute__((ext_vector_type(8)));
typedef unsigned u32x4 __attribute__((ext_vector_type(4)));
typedef unsigned u32x2 __attribute__((ext_vector_type(2)));
constexpr int NWAVES = 8, NTHR = 512;
constexpr int D = 1024, NB = 8, SEQ = 2048, CTXL = 256, MX = NB * SEQ, MC = NB * CTXL, MT = MX + MC;
constexpr int NIN = 2304, INW = 2320, FF = 2816;
constexpr int C_AQ = 0, C_AK = 512, C_AV = 640, C_MQ = 768, C_MK = 1024, C_MV = 1280, C_MO = 1792;
constexpr int NCH = 36;
constexpr int STSZ = 8256;
constexpr float EPSF = 1e-6f;
constexpr size_t MiB = 1u << 20;
constexpr size_t WS_MOD = 1 * MiB;
constexpr size_t WS_ROPE = 1 * MiB + 512 * 1024;
constexpr size_t WS_WIN = 2 * MiB, WS_WOUT = 7 * MiB, WS_WFI = 9 * MiB, WS_WFO = 20 * MiB;
constexpr size_t WS_GATES = 26 * MiB;
constexpr size_t WS_SCAL = 28 * MiB;
constexpr size_t WS_A = 30 * MiB;
constexpr size_t WS_PX = 66 * MiB;
constexpr size_t WS_QKS = 147 * MiB;
constexpr size_t WS_ST = 165 * MiB;
constexpr size_t WS_MIX = 66 * MiB;
constexpr size_t WS_H = 100 * MiB;
constexpr size_t WS_FX = 190 * MiB;
constexpr int LDS_BYTES = 139264;

struct Args {
    const float *x, *c, *ctx, *c_ctx, *w_ada, *b_ada, *g_pre_mix, *w_in, *w_conv, *b_gates, *sink, *g_ml, *w_out, *g_post_mix, *g_pre_ffn, *w_ffi, *w_ffo, *g_post_ffn;
    float* out; unsigned char* ws; int ph_lo, ph_hi;
};

__device__ __forceinline__ unsigned f2bf(float f) { unsigned u = __builtin_bit_cast(unsigned, f); return (u + 0x7fffu + ((u >> 16) & 1u)) >> 16; }
__device__ __forceinline__ unsigned pk2(float lo, float hi) { return f2bf(lo) | (f2bf(hi) << 16); }
__device__ __forceinline__ float bf2f(unsigned h) { return __builtin_bit_cast(float, h << 16); }
__device__ __forceinline__ float bflo(unsigned w) { return __builtin_bit_cast(float, w << 16); }
__device__ __forceinline__ float bfhi(unsigned w) { return __builtin_bit_cast(float, w & 0xffff0000u); }
__device__ __forceinline__ float wave_sum(float v) {
#pragma unroll
    for (int o = 1; o < 64; o <<= 1) v += __shfl_xor(v, o);
    return v;
}
__device__ __forceinline__ float wave_max(float v) {
#pragma unroll
    for (int o = 1; o < 64; o <<= 1) v = fmaxf(v, __shfl_xor(v, o));
    return v;
}
__device__ __forceinline__ float red16_sum(float v) { v += __shfl_xor(v, 1); v += __shfl_xor(v, 2); v += __shfl_xor(v, 4); v += __shfl_xor(v, 8); return v; }
__device__ __forceinline__ float red16_max(float v) { v = fmaxf(v, __shfl_xor(v, 1)); v = fmaxf(v, __shfl_xor(v, 2)); v = fmaxf(v, __shfl_xor(v, 4)); v = fmaxf(v, __shfl_xor(v, 8)); return v; }
__device__ __forceinline__ float logsig(float f) { return fminf(f, 0.f) - log1pf(expf(-fabsf(f))); }
__device__ __forceinline__ f32x4 mfma16(bf16x8 a, bf16x8 b, f32x4 c) { return __builtin_amdgcn_mfma_f32_16x16x32_bf16(a, b, c, 0, 0, 0); }
#define LDS_WAIT() asm volatile("s_waitcnt lgkmcnt(0)" ::: "memory")

__device__ __forceinline__ void transpose_item(const float* W, int ldw, int K, bf16* WT, int dst_row0, int k0, int n0, LAS float* scr, int lane) {
#pragma unroll 8
    for (int i = 0; i < 32; ++i) { const int kk = 2 * i + (lane >> 5); scr[kk * 33 + (lane & 31)] = W[(size_t)(k0 + kk) * ldw + n0 + (lane & 31)]; }
    LDS_WAIT(); asm volatile("" ::: "memory");
    const int c = lane & 7;
#pragma unroll
    for (int j = 0; j < 4; ++j) { const int n = (lane >> 3) + 8 * j; const LAS float* s = scr + (8 * c) * 33 + n;
        u32x4 o; o.x = pk2(s[0 * 33], s[1 * 33]); o.y = pk2(s[2 * 33], s[3 * 33]); o.z = pk2(s[4 * 33], s[5 * 33]); o.w = pk2(s[6 * 33], s[7 * 33]);
        *(u32x4*)(WT + (size_t)(dst_row0 + n) * K + k0 + 8 * c) = o; }
    LDS_WAIT(); asm volatile("" ::: "memory");
}

__device__ __forceinline__ void phase0(const Args& a, LAS unsigned char* lds, int tid, int lane, int wave, int G) {
    unsigned char* ws = a.ws;
    float* mod = (float*)(ws + WS_MOD);
    { float* rope = (float*)(ws + WS_ROPE);
      for (int i = blockIdx.x * NTHR + tid; i < 96 * 16; i += G * NTHR) { const int pos = i >> 4, f = i & 15; const float inv = powf(10000.0f, -(float)f / 16.0f);
          const float ang = (float)(pos < 32 ? pos : pos - 32) * inv; rope[2 * i] = cosf(ang); rope[2 * i + 1] = sinf(ang); } }
    for (int it = G - 1 - (int)blockIdx.x; it < 96; it += G) {
        LAS float* sv = (LAS float*)lds;
        LAS float* red = (LAS float*)(lds + 40960);
        for (int i = tid; i < 9 * 1024; i += NTHR) { const int r = i >> 10, k = i & 1023; const float cv = r < 8 ? a.c[r * 1024 + k] : a.c_ctx[k]; sv[i] = cv / (1.0f + expf(-cv)); }
        __syncthreads();
        const int cq = tid & 15, kg = tid >> 4, j0 = it * 64;
        f32x4 acc[9];
#pragma unroll
        for (int r = 0; r < 9; ++r) acc[r] = (f32x4){0.f, 0.f, 0.f, 0.f};
#pragma unroll 4
        for (int kk = 0; kk < 32; ++kk) { const int k = kg * 32 + kk; const f32x4 w = *(const f32x4*)(a.w_ada + (size_t)k * 6144 + j0 + cq * 4);
#pragma unroll
            for (int r = 0; r < 9; ++r) acc[r] += sv[r * 1024 + k] * w; }
#pragma unroll
        for (int r = 0; r < 9; ++r)
#pragma unroll
            for (int e = 0; e < 4; ++e) { float v = acc[r][e]; v += __shfl_xor(v, 16); v += __shfl_xor(v, 32); acc[r][e] = v; }
        if (lane < 16) {
#pragma unroll
            for (int r = 0; r < 9; ++r)
#pragma unroll
                for (int e = 0; e < 4; ++e) red[(wave * 9 + r) * 64 + cq * 4 + e] = acc[r][e];
        }
        __syncthreads();
        for (int i = tid; i < 9 * 64; i += NTHR) { const int r = i >> 6, col = i & 63; float s = a.b_ada[j0 + col];
#pragma unroll
            for (int w = 0; w < 8; ++w) s += red[(w * 9 + r) * 64 + col];
            mod[r * 6144 + j0 + col] = s; }
        __syncthreads();
    }
    LAS float* scr = (LAS float*)(lds + wave * 8448);
    const int gw = blockIdx.x * NWAVES + wave, NGW = G * NWAVES;
    constexpr int I_IN = 16 * 72, I_OUT = 16 * 32, I_FI = 16 * 176, I_FO = 44 * 32;
    for (int it = gw; it < I_IN + I_OUT + I_FI + I_FO; it += NGW) {
        int r = it;
        if (r < I_IN) { const int kb = r / 72, nb = r % 72; transpose_item(a.w_in, INW, D, (bf16*)(ws + WS_WIN), 32 * nb, 64 * kb, 32 * nb, scr, lane); continue; } r -= I_IN;
        if (r < I_OUT) { const int kb = r / 32, nb = r % 32; transpose_item(a.w_out, D, D, (bf16*)(ws + WS_WOUT), 32 * nb, 64 * kb, 32 * nb, scr, lane); continue; } r -= I_OUT;
        if (r < I_FI) { const int kb = r / 176, nb = r % 176; const int n0 = 32 * nb, bj = n0 >= FF ? 1 : 0, jj = n0 - bj * FF; const int dst = 256 * (jj >> 7) + 128 * bj + (jj & 127);
            transpose_item(a.w_ffi, 2 * FF, D, (bf16*)(ws + WS_WFI), dst, 64 * kb, n0, scr, lane); continue; } r -= I_FI;
        { const int kb = r / 32, nb = r % 32; transpose_item(a.w_ffo, D, FF, (bf16*)(ws + WS_WFO), 32 * nb, 64 * kb, 32 * nb, scr, lane); }
    }
}

__device__ __forceinline__ void phase1(const Args& a, LAS unsigned char* lds, int tid, int lane, int wave, int G) {
    unsigned char* ws = a.ws; const float* mod = (const float*)(ws + WS_MOD);
    bf16* A = (bf16*)(ws + WS_A); float* gates = (float*)(ws + WS_GATES);
    LAS f32x4* WgL = (LAS f32x4*)lds;
    for (int i = tid; i < 16384; i += NTHR) { const int k = i >> 4, j = i & 15; const int kpos = ((k >> 8) * 4 + (k & 3)) * 64 + ((k >> 2) & 63);
        ((LAS float*)lds)[((j >> 2) * 1024 + kpos) * 4 + (j & 3)] = a.w_in[(size_t)k * INW + NIN + j]; }
    __syncthreads();
    const int gw = blockIdx.x * NWAVES + wave, NGW = G * NWAVES;
    for (int row = gw; row < MT; row += NGW) {
        const float* xr = row < MX ? a.x + (size_t)row * D : a.ctx + (size_t)(row - MX) * D;
        const float* mrow = mod + (row < MX ? (row >> 11) : 8) * 6144;
        f32x4 v[4]; float ss = 0.f;
#pragma unroll
        for (int j = 0; j < 4; ++j) { v[j] = ((const f32x4*)xr)[lane + 64 * j]; ss += (v[j].x * v[j].x + v[j].y * v[j].y) + (v[j].z * v[j].z + v[j].w * v[j].w); }
        const float rstd = rsqrtf(wave_sum(ss) * (1.0f / D) + EPSF);
#pragma unroll
        for (int j = 0; j < 4; ++j) { const int k = 4 * lane + 256 * j;
            const f32x4 g = *(const f32x4*)(a.g_pre_mix + k), sh = *(const f32x4*)(mrow + k), sc = *(const f32x4*)(mrow + 1024 + k);
            v[j] = (v[j] * rstd * g) * (1.0f + sc) + sh;
            u32x2 o; o.x = pk2(v[j].x, v[j].y); o.y = pk2(v[j].z, v[j].w);
            *(u32x2*)(A + (size_t)row * D + k) = o; }
        float ga[16];
#pragma unroll
        for (int q = 0; q < 16; ++q) ga[q] = 0.f;
#pragma unroll
        for (int j = 0; j < 4; ++j)
#pragma unroll
            for (int c = 0; c < 4; ++c) { const int kpos = (j * 4 + c) * 64 + lane; const float av = v[j][c];
#pragma unroll
                for (int jq = 0; jq < 4; ++jq) { const f32x4 w = WgL[jq * 1024 + kpos]; ga[jq * 4 + 0] += av * w.x; ga[jq * 4 + 1] += av * w.y; ga[jq * 4 + 2] += av * w.z; ga[jq * 4 + 3] += av * w.w; }
                if (c & 1) __builtin_amdgcn_sched_barrier(0); }
        float mine = 0.f;
#pragma unroll
        for (int q = 0; q < 16; ++q) { const float s = wave_sum(ga[q]); if (lane == q) mine = s; }
        if (lane < 16) gates[(size_t)row * 16 + lane] = mine;
    }
}

__device__ __forceinline__ void attn_unit(const Args& a, LAS unsigned char* lds, int unit, int tid, int lane, int wave) {
    unsigned char* ws = a.ws; const bf16* px = (const bf16*)(ws + WS_PX); const float* rope = (const float*)(ws + WS_ROPE); bf16* mixcat = (bf16*)(ws + WS_A);
    const int hp = unit & 1, qb = (unit >> 1) & 15, hk = (unit >> 5) & 1, b = unit >> 6;
    LAS bf16* Qs = (LAS bf16*)lds;
    LAS bf16* Ks = (LAS bf16*)(lds + 36864);
    LAS bf16* VT = (LAS bf16*)(lds + 46080);
    LAS bf16* Pw = (LAS bf16*)(lds + 55296) + wave * (32 * 72);
    const int fr = lane & 15, fq = lane >> 4;
    __syncthreads();
#pragma unroll
    for (int tt = 0; tt < 2; ++tt) { const int task = tid + tt * NTHR; const int r = task >> 2, part = task & 3, half = part >> 1, sub = (part & 1) * 8;
        const int pos = qb * 128 + (r & 127), head = hk * 4 + hp * 2 + (r >> 7);
        const bf16* src = px + (size_t)(b * SEQ + pos) * NIN + C_AQ + head * 64 + half * 32 + sub;
        const u32x4 w1 = *(const u32x4*)src, w2 = *(const u32x4*)(src + 16);
        const float* tb = rope + ((half == 0 ? (pos >> 6) : 32 + (pos & 63)) * 16 + sub) * 2;
        u32x4 o1, o2;
#pragma unroll
        for (int i = 0; i < 4; ++i) { const f32x4 cs = *(const f32x4*)(tb + 4 * i);
            const float u1a = bflo(w1[i]), u1b = bfhi(w1[i]), u2a = bflo(w2[i]), u2b = bfhi(w2[i]);
            o1[i] = pk2(u1a * cs.x - u2a * cs.y, u1b * cs.z - u2b * cs.w); o2[i] = pk2(u2a * cs.x + u1a * cs.y, u2b * cs.z + u1b * cs.w); }
        *(LAS u32x4*)(Qs + r * 72 + half * 32 + sub) = o1; *(LAS u32x4*)(Qs + r * 72 + half * 32 + 16 + sub) = o2; }
    __syncthreads();
    bf16x8 qf[2][2];
#pragma unroll
    for (int rt = 0; rt < 2; ++rt)
#pragma unroll
        for (int kk = 0; kk < 2; ++kk) qf[rt][kk] = *(const LAS bf16x8*)(Qs + (wave * 32 + rt * 16 + fr) * 72 + kk * 32 + fq * 8);
    const int head = hk * 4 + hp * 2 + (wave >> 2);
    const float sinkv = a.sink[head];
    float mrun[2][4], lrun[2][4]; f32x4 O[2][4];
#pragma unroll
    for (int rt = 0; rt < 2; ++rt) {
#pragma unroll
        for (int j = 0; j < 4; ++j) { mrun[rt][j] = sinkv; lrun[rt][j] = (fr == 0) ? 1.0f : 0.0f; }
#pragma unroll
        for (int dt = 0; dt < 4; ++dt) O[rt][dt] = (f32x4){0.f, 0.f, 0.f, 0.f}; }
    const int qbase = qb * 128 + (wave & 3) * 32;
    for (int tile = 0; tile < 10; ++tile) {
        const bool lat = tile < 6; const int kt = qb * 2 - 2 + tile;
        if (lat && (kt < 0 || kt >= 32)) continue;
        const int key0 = lat ? kt * 64 : 0;
        const size_t krow0 = lat ? (size_t)(b * SEQ + key0) : (size_t)(MX + b * CTXL + (tile - 6) * 64);
        __syncthreads();
        if (lat) {
            if (tid < 256) { const int key = tid >> 2, part = tid & 3, half = part >> 1, sub = (part & 1) * 8; const int pos = key0 + key;
                const bf16* src = px + (krow0 + key) * NIN + C_AK + hk * 64 + half * 32 + sub;
                const u32x4 w1 = *(const u32x4*)src, w2 = *(const u32x4*)(src + 16);
                const float* tb = rope + ((half == 0 ? (pos >> 6) : 32 + (pos & 63)) * 16 + sub) * 2;
                u32x4 o1, o2;
#pragma unroll
                for (int i = 0; i < 4; ++i) { const f32x4 cs = *(const f32x4*)(tb + 4 * i);
                    const float u1a = bflo(w1[i]), u1b = bfhi(w1[i]), u2a = bflo(w2[i]), u2b = bfhi(w2[i]);
                    o1[i] = pk2(u1a * cs.x - u2a * cs.y, u1b * cs.z - u2b * cs.w); o2[i] = pk2(u2a * cs.x + u1a * cs.y, u2b * cs.z + u1b * cs.w); }
                *(LAS u32x4*)(Ks + key * 72 + half * 32 + sub) = o1; *(LAS u32x4*)(Ks + key * 72 + half * 32 + 16 + sub) = o2; }
        } else {
            const int key = tid >> 3, ck = tid & 7;
            *(LAS u32x4*)(Ks + key * 72 + ck * 8) = *(const u32x4*)(px + (krow0 + key) * NIN + C_AK + hk * 64 + ck * 8);
        }
        { const int key = tid >> 3, ck = tid & 7; const u32x4 w = *(const u32x4*)(px + (krow0 + key) * NIN + C_AV + hk * 64 + ck * 8);
#pragma unroll
          for (int i = 0; i < 4; ++i) { VT[(ck * 8 + 2 * i) * 72 + key] = (bf16)(w[i] & 0xffffu); VT[(ck * 8 + 2 * i + 1) * 72 + key] = (bf16)(w[i] >> 16); } }
        __syncthreads();
        f32x4 sc[2][4];
#pragma unroll
        for (int rt = 0; rt < 2; ++rt)
#pragma unroll
            for (int kt4 = 0; kt4 < 4; ++kt4) { f32x4 acc = (f32x4){0.f, 0.f, 0.f, 0.f};
#pragma unroll
                for (int kk = 0; kk < 2; ++kk) acc = mfma16(qf[rt][kk], *(const LAS bf16x8*)(Ks + (kt4 * 16 + fr) * 72 + kk * 32 + fq * 8), acc);
                sc[rt][kt4] = acc; }
#pragma unroll
        for (int rt = 0; rt < 2; ++rt)
#pragma unroll
            for (int j = 0; j < 4; ++j) { const int qpos = qbase + rt * 16 + fq * 4 + j; float mx = -INFINITY;
#pragma unroll
                for (int kt4 = 0; kt4 < 4; ++kt4) { float s = sc[rt][kt4][j] * 0.125f; const int dpos = qpos - (key0 + kt4 * 16 + fr);
                    if (lat && (dpos > 128 || dpos < -128)) s = -INFINITY; sc[rt][kt4][j] = s; mx = fmaxf(mx, s); }
                mx = red16_max(mx);
                const float mnew = fmaxf(mrun[rt][j], mx), alpha = __expf(mrun[rt][j] - mnew); mrun[rt][j] = mnew;
                float ps = 0.f;
#pragma unroll
                for (int kt4 = 0; kt4 < 4; ++kt4) { const float p = __expf(sc[rt][kt4][j] - mnew); ps += p; Pw[(rt * 16 + fq * 4 + j) * 72 + kt4 * 16 + fr] = (bf16)f2bf(p); }
                lrun[rt][j] = lrun[rt][j] * alpha + ps;
#pragma unroll
                for (int dt = 0; dt < 4; ++dt) O[rt][dt][j] *= alpha; }
        LDS_WAIT(); asm volatile("" ::: "memory");
#pragma unroll
        for (int rt = 0; rt < 2; ++rt)
#pragma unroll
            for (int kk = 0; kk < 2; ++kk) { const bf16x8 pa = *(const LAS bf16x8*)(Pw + (rt * 16 + fr) * 72 + kk * 32 + fq * 8);
#pragma unroll
                for (int dt = 0; dt < 4; ++dt) O[rt][dt] = mfma16(pa, *(const LAS bf16x8*)(VT + (dt * 16 + fr) * 72 + kk * 32 + fq * 8), O[rt][dt]); }
    }
#pragma unroll
    for (int rt = 0; rt < 2; ++rt)
#pragma unroll
        for (int j = 0; j < 4; ++j) { const float inv = 1.0f / red16_sum(lrun[rt][j]); const int qpos = qbase + rt * 16 + fq * 4 + j;
            bf16* orow = mixcat + (size_t)(b * SEQ + qpos) * D + head * 64 + fr;
#pragma unroll
            for (int dt = 0; dt < 4; ++dt) orow[dt * 16] = (bf16)f2bf(O[rt][dt][j] * inv); }
}

__device__ __forceinline__ void ml_local_unit(const Args& a, LAS unsigned char* lds, int unit, int tid, int lane, int wave) {
    unsigned char* ws = a.ws; const bf16* px = (const bf16*)(ws + WS_PX); const float* gates = (const float*)(ws + WS_GATES);
    bf16* qks = (bf16*)(ws + WS_QKS); float* scal = (float*)(ws + WS_SCAL); float* st = (float*)(ws + WS_ST);
    const int h = unit & 3, bc = unit >> 2, c36 = bc % NCH, b = bc / NCH;
    const int T = c36 < 4 ? CTXL : SEQ, t0 = c36 < 4 ? c36 * 64 : (c36 - 4) * 64;
    const size_t rowbase = c36 < 4 ? (size_t)(MX + b * CTXL) : (size_t)(b * SEQ);
    LAS float* gl = (LAS float*)lds;
    LAS bf16* KT = (LAS bf16*)(lds + 2048);
    LAS bf16* AV = (LAS bf16*)(lds + 2048 + 9216);
    const int fr = lane & 15, fq = lane >> 4;
    const int bhdF = (b * 4 + h) * 2, bhdB = bhdF + 1;
    __syncthreads();
    if (tid < 64) { const float* g = gates + (rowbase + t0 + tid) * 16;
        gl[tid] = logsig(g[4 + h] + a.b_gates[4 + h]); gl[64 + tid] = logsig(g[12 + h] + a.b_gates[12 + h]);
        gl[128 + tid] = g[h] + a.b_gates[h]; gl[192 + tid] = g[8 + h] + a.b_gates[8 + h]; }
    __syncthreads();
    if (tid < 64) { float sf = 0.f, pb = 0.f, totf = 0.f, totb = 0.f;
        for (int u = 0; u < 64; ++u) { const float lf = gl[u], lb = gl[64 + u]; totf += lf; totb += lb; if (u > tid) sf += lf; if (u < tid) pb += lb; }
        const float gf = sf + gl[128 + tid], gb = pb + gl[192 + tid];
        const float mf = wave_max(gf), mb = wave_max(gb);
        gl[256 + tid] = expf(gf - mf); gl[320 + tid] = expf(gb - mb);
        if (tid == 0) { scal[(bhdF * NCH + c36) * 2] = mf; scal[(bhdF * NCH + c36) * 2 + 1] = totf; scal[(bhdB * NCH + c36) * 2] = mb; scal[(bhdB * NCH + c36) * 2 + 1] = totb; } }
    { const int s = tid >> 3, cg8 = tid & 7, isk = cg8 >> 2, c0 = (cg8 & 3) * 16; const int col = (isk ? C_MK : C_MQ) + h * 64 + c0, wch = isk * 256 + h * 64 + c0; const int t = t0 + s;
      float acc[16];
#pragma unroll
      for (int i = 0; i < 16; ++i) acc[i] = 0.f;
#pragma unroll
      for (int dt = 0; dt < 3; ++dt) { const int tt = t + dt - 1; if (tt >= 0 && tt < T) { const bf16* src = px + (rowbase + tt) * NIN + col; const float* wc = a.w_conv + dt * 512 + wch;
#pragma unroll
          for (int hq = 0; hq < 2; ++hq) { const u32x4 w = *(const u32x4*)(src + 8 * hq);
#pragma unroll
              for (int i = 0; i < 4; ++i) { acc[hq * 8 + 2 * i] += wc[hq * 8 + 2 * i] * bflo(w[i]); acc[hq * 8 + 2 * i + 1] += wc[hq * 8 + 2 * i + 1] * bfhi(w[i]); } } } }
      const float qs = isk ? 1.0f : 0.125f;
#pragma unroll
      for (int i = 0; i < 16; ++i) { const float v = acc[i]; acc[i] = qs * v / (1.0f + expf(-v)); }
      u32x4 o0, o1;
#pragma unroll
      for (int i = 0; i < 4; ++i) { o0[i] = pk2(acc[2 * i], acc[2 * i + 1]); o1[i] = pk2(acc[8 + 2 * i], acc[8 + 2 * i + 1]); }
      bf16* dst = qks + (rowbase + t) * 512 + isk * 256 + h * 64 + c0; *(u32x4*)dst = o0; *(u32x4*)(dst + 8) = o1;
      if (isk) {
#pragma unroll
          for (int i = 0; i < 16; ++i) KT[(c0 + i) * 72 + s] = (bf16)f2bf(acc[i]); } }
    __syncthreads();
    { const int s = tid >> 3, vg = tid & 7; const bf16* src = px + (rowbase + t0 + s) * NIN + C_MV + h * 128 + vg * 16; const float wf = gl[256 + s], wb = gl[320 + s];
#pragma unroll
      for (int hq = 0; hq < 2; ++hq) { const u32x4 w = *(const u32x4*)(src + 8 * hq);
#pragma unroll
          for (int i = 0; i < 4; ++i) { const float v0 = bflo(w[i]), v1 = bfhi(w[i]); const int v = vg * 16 + hq * 8 + 2 * i;
              AV[v * 72 + s] = (bf16)f2bf(v0 * wf); AV[(v + 1) * 72 + s] = (bf16)f2bf(v1 * wf);
              AV[(128 + v) * 72 + s] = (bf16)f2bf(v0 * wb); AV[(128 + v + 1) * 72 + s] = (bf16)f2bf(v1 * wb); } } }
    __syncthreads();
#pragma unroll
    for (int dir = 0; dir < 2; ++dir) { float* dst = st + ((size_t)((bhdF + dir) * NCH + c36)) * STSZ;
#pragma unroll
        for (int dt = 0; dt < 4; ++dt) { f32x4 acc = (f32x4){0.f, 0.f, 0.f, 0.f};
#pragma unroll
            for (int kk = 0; kk < 2; ++kk) acc = mfma16(*(const LAS bf16x8*)(AV + (dir * 128 + wave * 16 + fr) * 72 + kk * 32 + fq * 8), *(const LAS bf16x8*)(KT + (dt * 16 + fr) * 72 + kk * 32 + fq * 8), acc);
#pragma unroll
            for (int j = 0; j < 4; ++j) dst[(wave * 16 + fq * 4 + j) * 64 + dt * 16 + fr] = acc[j]; } }
    if (tid < 128) { const int dir = tid >> 6, d = tid & 63; float s = 0.f;
        for (int u = 0; u < 64; ++u) s += gl[256 + dir * 64 + u] * bf2f(KT[d * 72 + u]);
        st[((size_t)((bhdF + dir) * NCH + c36)) * STSZ + 8192 + d] = s; }
}

__device__ __forceinline__ void phase4(const Args& a, int tid, int G) {
    unsigned char* ws = a.ws; float* st = (float*)(ws + WS_ST); const float* scal = (const float*)(ws + WS_SCAL); float* mprev = (float*)(ws + WS_SCAL + 65536);
    constexpr int NV = STSZ / 4;
    for (int ch = blockIdx.x * NTHR + tid; ch < 64 * NV; ch += G * NTHR) { const int bhd = ch / NV, e = ch - bhd * NV, dir = bhd & 1;
        float m = 0.f; f32x4 C = (f32x4){0.f, 0.f, 0.f, 0.f};
        for (int s0 = 0; s0 < NCH; s0 += 6) { f32x4 dd[6]; float ml[6], bl[6];
#pragma unroll
            for (int i = 0; i < 6; ++i) { const int step = s0 + i; const int c36 = dir == 0 ? step : (step < 4 ? 3 - step : 39 - step);
                dd[i] = *(const f32x4*)(st + ((size_t)(bhd * NCH + c36)) * STSZ + e * 4); ml[i] = scal[(bhd * NCH + c36) * 2]; bl[i] = scal[(bhd * NCH + c36) * 2 + 1]; }
#pragma unroll
            for (int i = 0; i < 6; ++i) { const int step = s0 + i; const int c36 = dir == 0 ? step : (step < 4 ? 3 - step : 39 - step);
                if (c36 >= 4) { *(f32x4*)(st + ((size_t)(bhd * NCH + c36)) * STSZ + e * 4) = C; if (e == 0) mprev[bhd * NCH + c36] = m; }
                const float mn = fmaxf(bl[i] + m, ml[i]); const float dec = expf(bl[i] + m - mn), sc = expf(ml[i] - mn);
                C = dec * C + sc * dd[i]; m = mn; } } }
}

__device__ __forceinline__ void ml_out_unit(const Args& a, LAS unsigned char* lds, int unit, int tid, int lane, int wave) {
    unsigned char* ws = a.ws; const bf16* px = (const bf16*)(ws + WS_PX); const float* gates = (const float*)(ws + WS_GATES);
    const bf16* qks = (const bf16*)(ws + WS_QKS); const float* st = (const float*)(ws + WS_ST); const float* mprev = (const float*)(ws + WS_SCAL + 65536); bf16* mixcat = (bf16*)(ws + WS_A);
    const int h = unit & 3, bc = unit >> 2, c = bc & 31, b = bc >> 5, c36 = c + 4;
    const size_t row0 = (size_t)(b * SEQ + c * 64);
    const int bhdF = (b * 4 + h) * 2;
    const float* stF = st + ((size_t)(bhdF * NCH + c36)) * STSZ; const float* stB = st + ((size_t)((bhdF + 1) * NCH + c36)) * STSZ;
    LAS float* gl = (LAS float*)lds;
    LAS bf16* Qs = (LAS bf16*)(lds + 8192);
    LAS bf16* Ks = (LAS bf16*)(lds + 8192 + 9216);
    LAS bf16* VT = (LAS bf16*)(lds + 8192 + 18432);
    LAS bf16* CF = (LAS bf16*)(lds + 8192 + 36864);
    LAS bf16* CB = (LAS bf16*)(lds + 8192 + 55296);
    LAS bf16* SF = (LAS bf16*)(lds + 8192 + 73728);
    LAS bf16* SB = (LAS bf16*)(lds + 8192 + 82944);
    enum { LFF = 0, LFB = 64, IGF = 128, IGB = 192, ROWF = 256, ROWB = 320, CCF = 384, CCB = 448, WIF = 512, WIB = 576, LOWF = 640, LOWB = 704, NF = 768, NBK = 832, QNF = 896, QNB = 960, RSP = 1024, SSQ = 1536 };
    const int fr = lane & 15, fq = lane >> 4;
    __syncthreads();
    if (tid < 64) { const float* g = gates + (row0 + tid) * 16;
        gl[LFF + tid] = logsig(g[4 + h] + a.b_gates[4 + h]); gl[LFB + tid] = logsig(g[12 + h] + a.b_gates[12 + h]);
        gl[IGF + tid] = g[h] + a.b_gates[h]; gl[IGB + tid] = g[8 + h] + a.b_gates[8 + h]; }
    else if (tid < 192) { const int dir = (tid - 64) >> 6, d = tid & 63; gl[NF + dir * 64 + d] = (dir ? stB : stF)[8192 + d]; }
    { const int s = tid >> 3, ck = tid & 7; const bf16* src = qks + (row0 + s) * 512 + h * 64 + ck * 8;
      *(LAS u32x4*)(Qs + s * 72 + ck * 8) = *(const u32x4*)src; *(LAS u32x4*)(Ks + s * 72 + ck * 8) = *(const u32x4*)(src + 256);
      const bf16* vs = px + (row0 + s) * NIN + C_MV + h * 128 + ck * 16;
#pragma unroll
      for (int hq = 0; hq < 2; ++hq) { const u32x4 w = *(const u32x4*)(vs + 8 * hq);
#pragma unroll
          for (int i = 0; i < 4; ++i) { const int v = ck * 16 + hq * 8 + 2 * i; VT[v * 72 + s] = (bf16)(w[i] & 0xffffu); VT[(v + 1) * 72 + s] = (bf16)(w[i] >> 16); } } }
    { const int v = tid >> 2, dq = tid & 3;
#pragma unroll
      for (int dir = 0; dir < 2; ++dir) { const float* src = (dir ? stB : stF) + v * 64 + dq * 16; LAS bf16* dst = (dir ? CB : CF) + v * 72 + dq * 16;
          const f32x4 x0 = *(const f32x4*)src, x1 = *(const f32x4*)(src + 4), x2 = *(const f32x4*)(src + 8), x3 = *(const f32x4*)(src + 12);
          u32x4 o0, o1; o0.x = pk2(x0.x, x0.y); o0.y = pk2(x0.z, x0.w); o0.z = pk2(x1.x, x1.y); o0.w = pk2(x1.z, x1.w); o1.x = pk2(x2.x, x2.y); o1.y = pk2(x2.z, x2.w); o1.z = pk2(x3.x, x3.y); o1.w = pk2(x3.z, x3.w);
          *(LAS u32x4*)dst = o0; *(LAS u32x4*)(dst + 8) = o1; } }
    __syncthreads();
    if (tid < 64) { const int t = tid; const float mpF = mprev[bhdF * NCH + c36], mpB = mprev[(bhdF + 1) * NCH + c36];
        { float run = 0.f, pmax = -INFINITY, bt = 0.f, ct = 0.f;
          for (int u = 0; u < 64; ++u) { run += gl[LFF + u]; const float cu = gl[IGF + u] - run; if (u <= t) pmax = fmaxf(pmax, cu); if (u == t) { bt = run; ct = cu; } }
          const float mt = bt + fmaxf(mpF, pmax); gl[ROWF + t] = bt - mt; gl[CCF + t] = ct; gl[WIF + t] = expf(bt + mpF - mt); gl[LOWF + t] = expf(-mt); }
        { float run = 0.f, pmax = -INFINITY, bt = 0.f, ct = 0.f;
          for (int u = 63; u >= 0; --u) { run += gl[LFB + u]; const float cu = gl[IGB + u] - run; if (u >= t) pmax = fmaxf(pmax, cu); if (u == t) { bt = run; ct = cu; } }
          const float mt = bt + fmaxf(mpB, pmax); gl[ROWB + t] = bt - mt; gl[CCB + t] = ct; gl[WIB + t] = expf(bt + mpB - mt); gl[LOWB + t] = expf(-mt); } }
    else if (tid >= 128 && tid < 256) { const int dir = (tid - 128) >> 6, t = tid & 63; float s = 0.f;
        for (int d = 0; d < 64; ++d) s += bf2f(Qs[t * 72 + d]) * gl[NF + dir * 64 + d];
        gl[QNF + dir * 64 + t] = s; }
    __syncthreads();
    { const int tt = wave & 3;
#pragma unroll
      for (int q = 0; q < 2; ++q) { const int stl = (wave >> 2) * 2 + q; f32x4 acc = (f32x4){0.f, 0.f, 0.f, 0.f};
#pragma unroll
          for (int kk = 0; kk < 2; ++kk) acc = mfma16(*(const LAS bf16x8*)(Qs + (tt * 16 + fr) * 72 + kk * 32 + fq * 8), *(const LAS bf16x8*)(Ks + (stl * 16 + fr) * 72 + kk * 32 + fq * 8), acc);
          const int s = stl * 16 + fr; const float cf = gl[CCF + s], cb = gl[CCB + s];
#pragma unroll
          for (int j = 0; j < 4; ++j) { const int t = tt * 16 + fq * 4 + j;
              const float wF = (s <= t) ? expf(gl[ROWF + t] + cf) : 0.f, wB = (s >= t) ? expf(gl[ROWB + t] + cb) : 0.f;
              const float sf = acc[j] * wF, sb = acc[j] * wB;
              SF[t * 72 + s] = (bf16)f2bf(sf); SB[t * 72 + s] = (bf16)f2bf(sb);
              const float rf = red16_sum(sf), rb = red16_sum(sb);
              if (fr == 0) { gl[RSP + t * 4 + stl] = rf; gl[RSP + 256 + t * 4 + stl] = rb; } } } }
    __syncthreads();
    { const int tt = wave & 3, vh = wave >> 2;
      f32x4 aS[2][4], aI[2][4];
#pragma unroll
      for (int dir = 0; dir < 2; ++dir)
#pragma unroll
          for (int vt = 0; vt < 4; ++vt) { aS[dir][vt] = (f32x4){0.f, 0.f, 0.f, 0.f}; aI[dir][vt] = (f32x4){0.f, 0.f, 0.f, 0.f}; }
#pragma unroll
      for (int kk = 0; kk < 2; ++kk) { const bf16x8 qa = *(const LAS bf16x8*)(Qs + (tt * 16 + fr) * 72 + kk * 32 + fq * 8);
          const bf16x8 sfa = *(const LAS bf16x8*)(SF + (tt * 16 + fr) * 72 + kk * 32 + fq * 8), sba = *(const LAS bf16x8*)(SB + (tt * 16 + fr) * 72 + kk * 32 + fq * 8);
#pragma unroll
          for (int vt = 0; vt < 4; ++vt) { const int vrow = (vh * 64 + vt * 16 + fr) * 72 + kk * 32 + fq * 8;
              const bf16x8 vb = *(const LAS bf16x8*)(VT + vrow);
              aS[0][vt] = mfma16(sfa, vb, aS[0][vt]); aS[1][vt] = mfma16(sba, vb, aS[1][vt]);
              aI[0][vt] = mfma16(qa, *(const LAS bf16x8*)(CF + vrow), aI[0][vt]); aI[1][vt] = mfma16(qa, *(const LAS bf16x8*)(CB + vrow), aI[1][vt]); } }
      float hv[4][4];
#pragma unroll
      for (int j = 0; j < 4; ++j) { const int t = tt * 16 + fq * 4 + j;
          const float wiF = gl[WIF + t], wiB = gl[WIB + t];
          const float denF = (gl[RSP + t * 4] + gl[RSP + t * 4 + 1]) + (gl[RSP + t * 4 + 2] + gl[RSP + t * 4 + 3]) + wiF * gl[QNF + t];
          const float denB = (gl[RSP + 256 + t * 4] + gl[RSP + 256 + t * 4 + 1]) + (gl[RSP + 256 + t * 4 + 2] + gl[RSP + 256 + t * 4 + 3]) + wiB * gl[QNB + t];
          const float iF = 1.0f / fmaxf(fabsf(denF), gl[LOWF + t]), iB = 1.0f / fmaxf(fabsf(denB), gl[LOWB + t]);
          float ss = 0.f;
#pragma unroll
          for (int vt = 0; vt < 4; ++vt) { const float hval = (aS[0][vt][j] + wiF * aI[0][vt][j]) * iF + (aS[1][vt][j] + wiB * aI[1][vt][j]) * iB; hv[vt][j] = hval; ss += hval * hval; }
          ss = red16_sum(ss);
          if (fr == 0) gl[SSQ + t * 2 + vh] = ss; }
      __syncthreads();
#pragma unroll
      for (int j = 0; j < 4; ++j) { const int t = tt * 16 + fq * 4 + j; const float rms = rsqrtf((gl[SSQ + t * 2] + gl[SSQ + t * 2 + 1]) * (1.0f / 128.0f) + EPSF);
          const bf16* mo = px + (row0 + t) * NIN + C_MO + h * 128 + vh * 64 + fr; bf16* orow = mixcat + (row0 + t) * D + 512 + h * 128 + vh * 64 + fr;
#pragma unroll
          for (int vt = 0; vt < 4; ++vt) { const float o = bf2f(mo[vt * 16]); const float y = hv[vt][j] * rms * a.g_ml[h * 128 + vh * 64 + vt * 16 + fr];
              orow[vt * 16] = (bf16)f2bf(y / (1.0f + expf(-o))); } } }
}

__device__ __forceinline__ void phase7(const Args& a, int lane, int wave, int G) {
    unsigned char* ws = a.ws; const float* mod = (const float*)(ws + WS_MOD); const bf16* mix = (const bf16*)(ws + WS_MIX); bf16* A = (bf16*)(ws + WS_A);
    const int gw = blockIdx.x * NWAVES + wave, NGW = G * NWAVES;
    for (int row = gw; row < MX; row += NGW) { const float* mrow = mod + (row >> 11) * 6144;
        f32x4 v[4]; float ss = 0.f;
#pragma unroll
        for (int j = 0; j < 4; ++j) { const u32x2 w = *(const u32x2*)(mix + (size_t)row * D + 4 * lane + 256 * j); v[j] = (f32x4){bflo(w.x), bfhi(w.x), bflo(w.y), bfhi(w.y)};
            ss += (v[j].x * v[j].x + v[j].y * v[j].y) + (v[j].z * v[j].z + v[j].w * v[j].w); }
        const float rstd = rsqrtf(wave_sum(ss) * (1.0f / D) + EPSF);
        float s2 = 0.f;
#pragma unroll
        for (int j = 0; j < 4; ++j) { const int k = 4 * lane + 256 * j; const f32x4 xv = *(const f32x4*)(a.x + (size_t)row * D + k);
            const f32x4 g = *(const f32x4*)(a.g_post_mix + k), gt = *(const f32x4*)(mrow + 2048 + k);
            v[j] = xv + gt * ((v[j] * rstd) * g); *(f32x4*)(a.out + (size_t)row * D + k) = v[j];
            s2 += (v[j].x * v[j].x + v[j].y * v[j].y) + (v[j].z * v[j].z + v[j].w * v[j].w); }
        const float rstd2 = rsqrtf(wave_sum(s2) * (1.0f / D) + EPSF);
#pragma unroll
        for (int j = 0; j < 4; ++j) { const int k = 4 * lane + 256 * j; const f32x4 g = *(const f32x4*)(a.g_pre_ffn + k), sh = *(const f32x4*)(mrow + 3072 + k), sc = *(const f32x4*)(mrow + 4096 + k);
            const f32x4 y = ((v[j] * rstd2) * g) * (1.0f + sc) + sh; u32x2 o; o.x = pk2(y.x, y.y); o.y = pk2(y.z, y.w); *(u32x2*)(A + (size_t)row * D + k) = o; } }
}
__device__ __forceinline__ void phase10(const Args& a, int lane, int wave, int G) {
    unsigned char* ws = a.ws; const float* mod = (const float*)(ws + WS_MOD); const bf16* fx = (const bf16*)(ws + WS_FX);
    const int gw = blockIdx.x * NWAVES + wave, NGW = G * NWAVES;
    for (int row = gw; row < MX; row += NGW) { const float* mrow = mod + (row >> 11) * 6144;
        f32x4 v[4]; float ss = 0.f;
#pragma unroll
        for (int j = 0; j < 4; ++j) { const u32x2 w = *(const u32x2*)(fx + (size_t)row * D + 4 * lane + 256 * j); v[j] = (f32x4){bflo(w.x), bfhi(w.x), bflo(w.y), bfhi(w.y)};
            ss += (v[j].x * v[j].x + v[j].y * v[j].y) + (v[j].z * v[j].z + v[j].w * v[j].w); }
        const float rstd = rsqrtf(wave_sum(ss) * (1.0f / D) + EPSF);
#pragma unroll
        for (int j = 0; j < 4; ++j) { const int k = 4 * lane + 256 * j; float* op = a.out + (size_t)row * D + k; const f32x4 xv = *(const f32x4*)op;
            const f32x4 g = *(const f32x4*)(a.g_post_ffn + k), gt = *(const f32x4*)(mrow + 5120 + k);
            *(f32x4*)op = xv + gt * ((v[j] * rstd) * g); } }
}

#include <cstdlib>
#include <vector>

#define XB_TMO      128
#define XB_XCNT(j)  (256  + 64 * (j))
#define XB_XSUB(j)  (1280 + 64 * (j))
#define XB_XGEN(j)  (2304 + 64 * (j))
#define XB_TOP      3328
#define XB_TOPGEN   3392
#define XCD_BAR_WORDS 3456
#define XB_SPIN_CAP (1u << 18)
__device__ __forceinline__ unsigned xb_ld(unsigned* p)              { return __hip_atomic_load(p, __ATOMIC_RELAXED, __HIP_MEMORY_SCOPE_AGENT); }
__device__ __forceinline__ unsigned xb_add(unsigned* p, unsigned v) { return __hip_atomic_fetch_add(p, v, __ATOMIC_RELAXED, __HIP_MEMORY_SCOPE_AGENT); }
__device__ __forceinline__ unsigned xb_xcc_id() { return (unsigned)__builtin_amdgcn_s_getreg((3 << 11) | 20) & 0xFu; }
#define XB_SPIN(cond, bar) do { unsigned _sp = 0; while (cond) { __builtin_amdgcn_s_sleep(1); \
    if ((++_sp & 255u) == 0u) { if (xb_ld(&(bar)[XB_TMO])) break; if (_sp > XB_SPIN_CAP) { atomicAdd(&(bar)[XB_TMO], 1u); break; } } } } while (0)

struct XcdBarrier {
    unsigned* bar; unsigned x;
    volatile LAS unsigned* st;
};

__device__ __forceinline__ XcdBarrier xcd_barrier_post(unsigned* bar, volatile LAS unsigned* st) {
    XcdBarrier b; b.bar = bar; b.x = xb_xcc_id(); b.st = st;
    if (threadIdx.x == 0) (void)xb_add(&bar[XB_XCNT(b.x)], 1u);
    return b;
}
__device__ __forceinline__ void xcd_barrier_complete(unsigned* bar, unsigned x, unsigned& nloc, unsigned& nx) {
    const unsigned G = gridDim.x * gridDim.y * gridDim.z;
    unsigned sum, cnt, mine, sp = 0u;
    for (;;) {
        sum = 0u; cnt = 0u; mine = 0u;
#pragma unroll
        for (unsigned j = 0; j < 16; ++j) { const unsigned c = xb_ld(&bar[XB_XCNT(j)]); sum += c; cnt += (c > 0u) ? 1u : 0u; mine = (j == x) ? c : mine; }
        if (sum == G) break;
        __builtin_amdgcn_s_sleep(1);
        if ((++sp & 255u) == 0u) { if (xb_ld(&bar[XB_TMO])) break; if (sp > XB_SPIN_CAP) { atomicAdd(&bar[XB_TMO], 1u); break; } }
    }
    nloc = mine > 0u ? mine : 1u; nx = cnt > 0u ? cnt : 1u;
}

__device__ __forceinline__ void xcd_barrier(const XcdBarrier& b) {
    asm volatile("s_waitcnt vmcnt(0)" ::: "memory");
    __syncthreads();
    if (threadIdx.x == 0) {
        unsigned* bar = b.bar;
        __builtin_amdgcn_s_waitcnt(0);
        unsigned nloc = b.st[0], nx = b.st[1];
        if (nloc == 0u) { xcd_barrier_complete(bar, b.x, nloc, nx); b.st[0] = nloc; b.st[1] = nx; }
        const unsigned old = xb_add(&bar[XB_XSUB(b.x)], 1u);
        const unsigned gen = old / nloc;
        if (old + 1u == (gen + 1u) * nloc) {
            __builtin_amdgcn_fence(__ATOMIC_RELEASE, "agent");
            asm volatile("s_waitcnt vmcnt(0)" ::: "memory");
            const unsigned og = xb_add(&bar[XB_TOP], 1u);
            const unsigned tg = og / nx;
            if (og + 1u == (tg + 1u) * nx) xb_add(&bar[XB_TOPGEN], 1u);
            else XB_SPIN(xb_ld(&bar[XB_TOPGEN]) == tg, bar);
            __builtin_amdgcn_fence(__ATOMIC_ACQUIRE, "agent");
            xb_add(&bar[XB_XGEN(b.x)], 1u);
            asm volatile("s_waitcnt vmcnt(0)" ::: "memory");
        } else {
            XB_SPIN(xb_ld(&bar[XB_XGEN(b.x)]) == gen, bar);
            __builtin_amdgcn_fence(__ATOMIC_ACQUIRE, "agent");
            asm volatile("s_waitcnt vmcnt(0)" ::: "memory");
        }
    }
    __syncthreads();
}

__global__ void __launch_bounds__(NTHR, 2) fwd_kernel(Args a) {
    extern __shared__ __attribute__((aligned(16))) unsigned char lds_raw[];
    LAS unsigned char* lds = (LAS unsigned char*)lds_raw;
    cg::grid_group grid = cg::this_grid();
    const int tid = threadIdx.x, lane = tid & 63, wave = __builtin_amdgcn_readfirstlane(tid >> 6), G = gridDim.x;
    const int lo = a.ph_lo, hi = a.ph_hi;
    unsigned char* ws = a.ws;
#ifndef PHASE_MASK
#define PHASE_MASK 0x7ff
#endif
#define IN(k) (((PHASE_MASK >> (k)) & 1) && lo <= (k) && (k) < hi)
#define SEAM(k) do { if (IN(k) && IN((k) + 1)) { xcd_barrier(xbar); } } while (0)
    if (tid < 4) ((LAS unsigned*)(lds + 131072))[tid] = 0u;
    __syncthreads();
    XcdBarrier xbar = xcd_barrier_post((unsigned*)ws, (volatile LAS unsigned*)(lds + 131072));
    if (lo > 1000) grid.sync();
    if (IN(0)) { phase0(a, lds, tid, lane, wave, G); } SEAM(0);
    if (IN(1)) { phase1(a, lds, tid, lane, wave, G); } SEAM(1);
    if (IN(2)) { __syncthreads(); pg8::Gemm g{(const pg8::bf16_t*)(ws + WS_A), (const pg8::bf16_t*)(ws + WS_WIN), MT, NIN, D}; pg8::StaticOrder S; S.init(MT, NIN, G, (int)blockIdx.x);
        pg8::EpiBf16 E{(pg8::bf16_t*)(ws + WS_PX), NIN}; pg8::gemm_phase<pg8::EpiBf16, pg8::StaticOrder, true, true>(lds, g, S, E); } SEAM(2);
    if (IN(3)) { for (int u = blockIdx.x; u < 512; u += G) attn_unit(a, lds, u, tid, lane, wave);
        for (int u = blockIdx.x; u < NB * NCH * 4; u += G) ml_local_unit(a, lds, u, tid, lane, wave); } SEAM(3);
    if (IN(4)) { phase4(a, tid, G); } SEAM(4);
    if (IN(5)) { for (int u = blockIdx.x; u < NB * 32 * 4; u += G) ml_out_unit(a, lds, u, tid, lane, wave); } SEAM(5);
    if (IN(6)) { __syncthreads(); pg8::Gemm g{(const pg8::bf16_t*)(ws + WS_A), (const pg8::bf16_t*)(ws + WS_WOUT), MX, D, D}; pg8::StaticOrder S; S.init(MX, D, G, (int)blockIdx.x);
        pg8::EpiBf16 E{(pg8::bf16_t*)(ws + WS_MIX), D}; pg8::gemm_phase<pg8::EpiBf16, pg8::StaticOrder, true, true>(lds, g, S, E); } SEAM(6);
    if (IN(7)) { phase7(a, lane, wave, G); } SEAM(7);
    if (IN(8)) { __syncthreads(); pg8::Gemm g{(const pg8::bf16_t*)(ws + WS_A), (const pg8::bf16_t*)(ws + WS_WFI), MX, 2 * FF, D}; pg8::StaticOrder S; S.init(MX, 2 * FF, G, (int)blockIdx.x);
        pg8::EpiSwiglu E{(pg8::bf16_t*)(ws + WS_H), FF}; pg8::gemm_phase<pg8::EpiSwiglu, pg8::StaticOrder, true, true>(lds, g, S, E); } SEAM(8);
    if (IN(9)) { __syncthreads(); pg8::Gemm g{(const pg8::bf16_t*)(ws + WS_H), (const pg8::bf16_t*)(ws + WS_WFO), MX, D, FF}; pg8::StaticOrder S; S.init(MX, D, G, (int)blockIdx.x);
        pg8::EpiBf16 E{(pg8::bf16_t*)(ws + WS_FX), D}; pg8::gemm_phase<pg8::EpiBf16, pg8::StaticOrder, true, true>(lds, g, S, E); } SEAM(9);
    if (IN(10)) { phase10(a, lane, wave, G); }
#undef IN
#undef SEAM
}

#ifndef N_LAUNCH_MODE
#define N_LAUNCH_MODE 1
#endif
extern "C" void kernel_launch(void* const* d_in, const int* in_sizes, int n_in, void* d_out, int out_size, void* d_ws, size_t ws_size, hipStream_t stream) {
    static int grid = 0;
    if (grid == 0) {
        int dev = 0, cus = 0, per_cu = 0;
        hipGetDevice(&dev); hipDeviceGetAttribute(&cus, hipDeviceAttributeMultiprocessorCount, dev);
        if (hipFuncSetAttribute((const void*)fwd_kernel, hipFuncAttributeMaxDynamicSharedMemorySize, LDS_BYTES) != hipSuccess) { fprintf(stderr, "kernel_launch: hipFuncSetAttribute failed\n"); grid = -1; return; }
        if (hipOccupancyMaxActiveBlocksPerMultiprocessor(&per_cu, (const void*)fwd_kernel, NTHR, LDS_BYTES) != hipSuccess || per_cu < 1) { fprintf(stderr, "kernel_launch: occupancy query says %d\n", per_cu); per_cu = 1; }
        (void)hipGetLastError();
        grid = cus * 1;
        if (grid <= 0) grid = 256;
    }
    if (grid < 0) return;
    Args a{};
    const float** ap = (const float**)&a;
    for (int i = 0; i < 18; ++i) ap[i] = (const float*)d_in[i];
    a.out = (float*)d_out; a.ws = (unsigned char*)d_ws;
    if (hipMemsetAsync(d_ws, 0, 16384, stream) != hipSuccess) { fprintf(stderr, "kernel_launch: memset of barrier words failed\n"); return; }
#if N_LAUNCH_MODE == 1
    a.ph_lo = 0; a.ph_hi = 11;
    { void* args[] = {&a}; hipError_t e = hipLaunchCooperativeKernel((const void*)fwd_kernel, dim3(grid), dim3(NTHR), args, LDS_BYTES, stream);
      if (e != hipSuccess) fprintf(stderr, "cooperative launch failed: %s (grid %d)\n", hipGetErrorString(e), grid); }
#else
    for (int p = 0; p < 11; ++p) { a.ph_lo = p; a.ph_hi = p + 1; void* args[] = {&a};
        hipError_t e = hipLaunchCooperativeKernel((const void*)fwd_kernel, dim3(grid), dim3(NTHR), args, LDS_BYTES, stream);
        if (e != hipSuccess) { fprintf(stderr, "launch %d failed: %s (grid %d)\n", p, hipGetErrorString(e), grid); break; } }
#endif
}
```

```cpp
#include <hip/hip_runtime.h>
#include <hip/hip_cooperative_groups.h>
#include <cstdio>
#include <cstdint>
namespace cg = cooperative_groups;
namespace pg8 {
#define PG8_LAS __attribute__((address_space(3)))
typedef unsigned short bf16_t;
typedef short bf16x8 __attribute__((ext_vector_type(8)));
typedef float f32x4 __attribute__((ext_vector_type(4)));
typedef unsigned u32x4 __attribute__((ext_vector_type(4)));
constexpr int BM = 256, BK = 64, HALF = 128, HTB = HALF * BK * 2  , STAGE_BYTES = 8 * HTB, NXCD = 8, WGM = 8;

__host__ __device__ __forceinline__ int lds_byte(int r, int c) { const int st = (r >> 4) * 2 + (c >> 5), rr = r & 15, cc = c & 31, ob = rr * 64 + cc * 2; return st * 1024 + (ob ^ (((ob >> 9) & 1) << 5)); }
__host__ __device__ __forceinline__ void stage_rc(int b, int& R, int& C) { const int st = b / 1024, sb = b % 1024, swz = sb ^ (((sb >> 9) & 1) << 5); R = (st >> 1) * 16 + swz / 64; C = (st & 1) * 32 + (swz % 64) / 2; }
__host__ __device__ __forceinline__ int perm32(int rho) { const int n = rho >> 4, i = rho & 15; return 8 * (i >> 2) + 4 * n + (i & 3); }

struct Unit { int pm, pn; };
struct Gemm { const bf16_t* A; const bf16_t* Bt; int M, N, K; };

struct StaticOrder {
    int nM, nN, nwg, G, c;
    __host__ __device__ void init(int M, int N, int G_, int c_) { nM = M / BM; nN = N / BM; nwg = nM * nN; G = G_; c = c_; }
    __host__ __device__ bool next(int i, Unit& u) const {
        const long L = (long)i * G + c; if (L >= nwg) return false;
        int wgid = (int)L; { const int q = nwg / NXCD, r = nwg % NXCD, xcd = wgid % NXCD, off = wgid / NXCD; wgid = (xcd < r ? xcd * (q + 1) : r * (q + 1) + (xcd - r) * q) + off; }
        const int nig = WGM * nN, gid = wgid / nig, fm = gid * WGM, gsz = (nM - fm) < WGM ? (nM - fm) : WGM;
        u.pm = fm + ((wgid % nig) % gsz); u.pn = (wgid % nig) / gsz; return true;
    }
    __device__ __forceinline__ void a_ready(const Unit&) const {}
    __device__ __forceinline__ void done(const Unit&) const {}
};

__device__ __forceinline__ unsigned cvt_pk_bf16(float lo, float hi) { unsigned r; asm volatile("v_cvt_pk_bf16_f32 %0, %1, %2" : "=v"(r) : "v"(lo), "v"(hi)); return r; }
struct EpiBf16 {
    static constexpr bool PERM = true, AFTER_DRAIN = false;
    bf16_t* O; int ldc;
    __device__ __forceinline__ void operator()(const f32x4 (&acc)[2][2][4][2], const Unit& u, int wr, int wc, int fr, int fq) const {
        const int row0 = u.pm * BM + wr * 64 + fr; const int col0 = u.pn * BM + wc * 32 + 8 * fq;
#pragma unroll
        for (int ai = 0; ai < 2; ++ai)
#pragma unroll
            for (int m = 0; m < 4; ++m) { bf16_t* rowp = O + (size_t)(row0 + ai * HALF + m * 16) * ldc + col0;
#pragma unroll
                for (int bj = 0; bj < 2; ++bj) { const f32x4 v0 = acc[ai][bj][m][0], v1 = acc[ai][bj][m][1];
                    u32x4 w; w.x = cvt_pk_bf16(v0[0], v0[1]); w.y = cvt_pk_bf16(v0[2], v0[3]); w.z = cvt_pk_bf16(v1[0], v1[1]); w.w = cvt_pk_bf16(v1[2], v1[3]);
                    *(u32x4*)(rowp + bj * HALF) = w; } }
    }
};
__device__ __forceinline__ float silu_f(float g) { return g * __builtin_amdgcn_rcpf(1.0f + __builtin_amdgcn_exp2f(-1.44269504089f * g)); }
struct EpiSwiglu {
    static constexpr bool PERM = true, AFTER_DRAIN = false;
    bf16_t* O; int ldc;
    __device__ __forceinline__ void operator()(const f32x4 (&acc)[2][2][4][2], const Unit& u, int wr, int wc, int fr, int fq) const {
        const int row0 = u.pm * BM + wr * 64 + fr; const int col0 = u.pn * HALF + wc * 32 + 8 * fq;
#pragma unroll
        for (int ai = 0; ai < 2; ++ai)
#pragma unroll
            for (int m = 0; m < 4; ++m) { bf16_t* rowp = O + (size_t)(row0 + ai * HALF + m * 16) * ldc + col0;
                const f32x4 g0 = acc[ai][0][m][0], g1 = acc[ai][0][m][1], u0 = acc[ai][1][m][0], u1 = acc[ai][1][m][1];
                u32x4 w; w.x = cvt_pk_bf16(silu_f(g0[0]) * u0[0], silu_f(g0[1]) * u0[1]); w.y = cvt_pk_bf16(silu_f(g0[2]) * u0[2], silu_f(g0[3]) * u0[3]);
                w.z = cvt_pk_bf16(silu_f(g1[0]) * u1[0], silu_f(g1[1]) * u1[1]); w.w = cvt_pk_bf16(silu_f(g1[2]) * u1[2], silu_f(g1[3]) * u1[3]);
                *(u32x4*)rowp = w; }
    }
};
struct EpiInProj {
    static constexpr bool PERM = true, AFTER_DRAIN = false;
    bf16_t* O; int ldc; float* gates;
    __device__ __forceinline__ void operator()(const f32x4 (&acc)[2][2][4][2], const Unit& u, int wr, int wc, int fr, int fq) const {
        const int row0 = u.pm * BM + wr * 64 + fr;
        if (u.pn == 9) {
            if (wc == 0 && fq < 2) {
#pragma unroll
                for (int ai = 0; ai < 2; ++ai)
#pragma unroll
                    for (int m = 0; m < 4; ++m) { float* gp = gates + (size_t)(row0 + ai * HALF + m * 16) * 16 + 8 * fq; *(f32x4*)gp = acc[ai][0][m][0]; *(f32x4*)(gp + 4) = acc[ai][0][m][1]; }
            }
            return;
        }
        const int col0 = u.pn * BM + wc * 32 + 8 * fq;
#pragma unroll
        for (int ai = 0; ai < 2; ++ai)
#pragma unroll
            for (int m = 0; m < 4; ++m) { bf16_t* rowp = O + (size_t)(row0 + ai * HALF + m * 16) * ldc + col0;
#pragma unroll
                for (int bj = 0; bj < 2; ++bj) { const f32x4 v0 = acc[ai][bj][m][0], v1 = acc[ai][bj][m][1];
                    u32x4 w; w.x = cvt_pk_bf16(v0[0], v0[1]); w.y = cvt_pk_bf16(v0[2], v0[3]); w.z = cvt_pk_bf16(v1[0], v1[1]); w.w = cvt_pk_bf16(v1[2], v1[3]);
                    *(u32x4*)(rowp + bj * HALF) = w; } }
    }
};
template <class Epi, class Sched, bool ALIGN_EPI = false, bool SP2 = false>
__device__ __forceinline__ void gemm_phase(PG8_LAS unsigned char* lds, const Gemm g, const Sched& S, const Epi& E) {
    const int tid = threadIdx.x, wid = __builtin_amdgcn_readfirstlane(tid >> 6), lane = tid & 63, wr = wid >> 2, wc = wid & 3, fr = lane & 15, fq = lane >> 4;
    const int K = g.K, nt = K / BK;
    unsigned voffA[2], voffB[2];
#pragma unroll
    for (int i = 0; i < 2; ++i) { int R, C; stage_rc(tid * 16 + i * 8192, R, C); const int Rb = Epi::PERM ? ((R & ~31) + perm32(R & 31)) : R;
        voffA[i] = (unsigned)(R * K + C) * 2u; voffB[i] = (unsigned)(Rb * K + C) * 2u; }
    const size_t kstep = (size_t)(BK * 2);
    const size_t hstep = (size_t)HALF * K * 2;
    const size_t tstep = 2 * hstep;
    const unsigned ldsw = (unsigned)wid * 1024u;
    const int aoff = lds_byte(wr * 64 + fr, fq * 8), boff = lds_byte(wc * 32 + fr, fq * 8);
#define PG8_SA(b, h) (((b) * 2 + (h)) * HTB)
#define PG8_SB(b, h) ((4 + (b) * 2 + (h)) * HTB)
#define PG8_STAGE(bufoff, gbase, voff) do { _Pragma("unroll") for (int _i = 0; _i < 2; ++_i) \
        __builtin_amdgcn_global_load_lds((const unsigned*)((const char*)(gbase) + (voff)[_i]), (PG8_LAS unsigned*)(lds + (bufoff) + ldsw + _i * 8192), 16, 0, 0); } while (0)
#define PG8_LDA(dst, b, h) do { _Pragma("unroll") for (int m = 0; m < 4; ++m) _Pragma("unroll") for (int k = 0; k < 2; ++k) dst[m][k] = *(const PG8_LAS bf16x8*)(lds + PG8_SA(b, h) + aoff + m * 2048 + k * 1024); } while (0)
#define PG8_LDB(dst, b, h) do { _Pragma("unroll") for (int n = 0; n < 2; ++n) _Pragma("unroll") for (int k = 0; k < 2; ++k) dst[n][k] = *(const PG8_LAS bf16x8*)(lds + PG8_SB(b, h) + boff + n * 2048 + k * 1024); } while (0)
#define PG8_MMA(ai, bj, At, Bt) do { __builtin_amdgcn_s_setprio(1); _Pragma("unroll") for (int m = 0; m < 4; ++m) _Pragma("unroll") for (int n = 0; n < 2; ++n) _Pragma("unroll") for (int k = 0; k < 2; ++k) \
        acc[ai][bj][m][n] = __builtin_amdgcn_mfma_f32_16x16x32_bf16(Bt[n][k], At[m][k], acc[ai][bj][m][n], 0, 0, 0); __builtin_amdgcn_s_setprio(0); } while (0)
#define PG8_WAIT_V(n) asm volatile("s_waitcnt vmcnt(" #n ")" ::: "memory")
#define PG8_WAIT_L(n) asm volatile("s_waitcnt lgkmcnt(" #n ")" ::: "memory")
#define PG8_BAR __builtin_amdgcn_s_barrier()
#define PG8_SCHED __builtin_amdgcn_sched_barrier(0)
    Unit cur, nxt; int ui = 0;
    if (!S.next(0, cur)) return;
    f32x4 acc[2][2][4][2];
#pragma unroll
    for (int a = 0; a < 2; ++a)
#pragma unroll
        for (int b = 0; b < 2; ++b)
#pragma unroll
            for (int m = 0; m < 4; ++m)
#pragma unroll
                for (int n = 0; n < 2; ++n) acc[a][b][m][n] = (f32x4){0.f, 0.f, 0.f, 0.f};
    bf16x8 At[4][2], B0[2][2], B1[2][2];
    const char* cA = (const char*)g.A + (size_t)cur.pm * tstep; const char* cB = (const char*)g.Bt + (size_t)cur.pn * tstep;
    S.a_ready(cur);
    if constexpr (SP2) {
        PG8_STAGE(PG8_SB(0, 0), cB, voffB); PG8_STAGE(PG8_SB(0, 1), cB + hstep, voffB); PG8_STAGE(PG8_SA(0, 0), cA, voffA); PG8_STAGE(PG8_SA(0, 1), cA + hstep, voffA);
        if (wr == 1) PG8_BAR;
        PG8_WAIT_V(2); PG8_BAR;
        PG8_STAGE(PG8_SB(1, 0), cB + kstep, voffB); PG8_STAGE(PG8_SA(1, 0), cA + kstep, voffA); PG8_STAGE(PG8_SB(1, 1), cB + hstep + kstep, voffB);
        PG8_WAIT_V(6); PG8_BAR;
    } else {
        PG8_STAGE(PG8_SB(0, 0), cB, voffB); PG8_STAGE(PG8_SA(0, 0), cA, voffA); PG8_STAGE(PG8_SB(0, 1), cB + hstep, voffB); PG8_STAGE(PG8_SA(0, 1), cA + hstep, voffA);
        if (wr == 1) PG8_BAR;
        PG8_WAIT_V(4); PG8_BAR;
        PG8_STAGE(PG8_SB(1, 0), cB + kstep, voffB); PG8_STAGE(PG8_SA(1, 0), cA + kstep, voffA); PG8_STAGE(PG8_SB(1, 1), cB + hstep + kstep, voffB);
        PG8_WAIT_V(6); PG8_BAR;
    }
    for (;;) {
        const bool has_next = S.next(ui + 1, nxt);
        const char* nA = has_next ? (const char*)g.A + (size_t)nxt.pm * tstep : cA; const char* nB = has_next ? (const char*)g.Bt + (size_t)nxt.pn * tstep : cB;
        for (int t = 0; t < nt; t += 2) {
            const bool last = (t == nt - 2);
            const char* a1 = cA + (size_t)(t + 1) * kstep;
            const char* a2 = last ? nA : cA + (size_t)(t + 2) * kstep; const char* b2 = last ? nB : cB + (size_t)(t + 2) * kstep;
            const char* a3 = a2 + kstep; const char* b3 = b2 + kstep;
            if (last && has_next) S.a_ready(nxt);
            if constexpr (SP2) {
            PG8_LDB(B0, 0, 0); PG8_LDB(B1, 0, 1); PG8_SCHED; PG8_LDA(At, 0, 0); PG8_STAGE(PG8_SA(1, 1), a1 + hstep, voffA);
            PG8_WAIT_V(8); PG8_WAIT_L(0); PG8_BAR; PG8_MMA(0, 0, At, B0); PG8_MMA(0, 1, At, B1); PG8_BAR; PG8_SCHED;
            PG8_LDA(At, 0, 1); PG8_STAGE(PG8_SB(0, 0), b2, voffB); PG8_STAGE(PG8_SB(0, 1), b2 + hstep, voffB); PG8_STAGE(PG8_SA(0, 0), a2, voffA);
            PG8_WAIT_V(8); PG8_WAIT_L(0); PG8_BAR; PG8_MMA(1, 0, At, B0); PG8_MMA(1, 1, At, B1); PG8_BAR; PG8_SCHED;
            PG8_LDB(B0, 1, 0); PG8_LDB(B1, 1, 1); PG8_SCHED; PG8_LDA(At, 1, 0); PG8_STAGE(PG8_SA(0, 1), a2 + hstep, voffA);
            PG8_WAIT_V(8); PG8_WAIT_L(0); PG8_BAR; PG8_MMA(0, 0, At, B0); PG8_MMA(0, 1, At, B1); PG8_BAR; PG8_SCHED;
            PG8_LDA(At, 1, 1); PG8_STAGE(PG8_SB(1, 0), b3, voffB); PG8_STAGE(PG8_SB(1, 1), b3 + hstep, voffB); PG8_STAGE(PG8_SA(1, 0), a3, voffA);
            PG8_WAIT_V(8); PG8_WAIT_L(0); PG8_BAR; PG8_MMA(1, 0, At, B0); PG8_MMA(1, 1, At, B1); PG8_BAR; PG8_SCHED;
            } else {
            PG8_LDB(B0, 0, 0); PG8_SCHED; PG8_LDA(At, 0, 0); PG8_STAGE(PG8_SA(1, 1), a1 + hstep, voffA);
            PG8_WAIT_L(8); PG8_BAR; PG8_WAIT_L(0); PG8_MMA(0, 0, At, B0); PG8_BAR; PG8_SCHED;
            PG8_LDB(B1, 0, 1); PG8_STAGE(PG8_SB(0, 0), b2, voffB);
            PG8_BAR; PG8_WAIT_L(0); PG8_MMA(0, 1, At, B1); PG8_BAR;
            PG8_LDA(At, 0, 1); PG8_STAGE(PG8_SA(0, 0), a2, voffA);
            PG8_BAR; PG8_WAIT_L(0); PG8_MMA(1, 0, At, B0); PG8_BAR; PG8_SCHED;
            PG8_STAGE(PG8_SB(0, 1), b2 + hstep, voffB);
            PG8_WAIT_V(6); PG8_BAR; PG8_MMA(1, 1, At, B1); PG8_BAR;
            PG8_LDB(B0, 1, 0); PG8_SCHED; PG8_LDA(At, 1, 0); PG8_STAGE(PG8_SA(0, 1), a2 + hstep, voffA);
            PG8_WAIT_L(8); PG8_BAR; PG8_WAIT_L(0); PG8_MMA(0, 0, At, B0); PG8_BAR; PG8_SCHED;
            PG8_LDB(B1, 1, 1); PG8_STAGE(PG8_SB(1, 0), b3, voffB);
            PG8_BAR; PG8_WAIT_L(0); PG8_MMA(0, 1, At, B1); PG8_BAR;
            PG8_LDA(At, 1, 1); PG8_STAGE(PG8_SA(1, 0), a3, voffA);
            PG8_BAR; PG8_WAIT_L(0); PG8_MMA(1, 0, At, B0); PG8_BAR; PG8_SCHED;
            PG8_STAGE(PG8_SB(1, 1), b3 + hstep, voffB);
            PG8_WAIT_V(6); PG8_BAR; PG8_MMA(1, 1, At, B1); PG8_BAR;
            }
        }
        if constexpr (ALIGN_EPI) { if (wr == 0) PG8_BAR; }
        if constexpr (!Epi::AFTER_DRAIN) { E(acc, cur, wr, wc, fr, fq); S.done(cur); }
        if (!has_next) break;
#pragma unroll
        for (int a = 0; a < 2; ++a)
#pragma unroll
            for (int b = 0; b < 2; ++b)
#pragma unroll
                for (int m = 0; m < 4; ++m)
#pragma unroll
                    for (int n = 0; n < 2; ++n) acc[a][b][m][n] = (f32x4){0.f, 0.f, 0.f, 0.f};
        cur = nxt; cA = nA; cB = nB; ++ui;
        if constexpr (ALIGN_EPI) { if (wr == 1) PG8_BAR; }
    }
    PG8_WAIT_V(0);
    if constexpr (!ALIGN_EPI) { if (wr == 0) PG8_BAR; }
    PG8_BAR;
    if constexpr (Epi::AFTER_DRAIN) { E.fused(acc, cur, wr, wc, fr, fq, lds, wid, lane); S.done(cur); }
#undef PG8_SA
#undef PG8_SB
#undef PG8_STAGE
#undef PG8_LDA
#undef PG8_LDB
#undef PG8_MMA
#undef PG8_WAIT_V
#undef PG8_WAIT_L
#undef PG8_BAR
#undef PG8_SCHED
}
}

#define LAS __attribute__((address_space(3)))
typedef unsigned short bf16;
typedef float f32x4 __attribute__((ext_vector_type(4)));
typedef float f32x2 __attribute__((ext_vector_type(2)));
typedef short bf16x8 __attribute__((ext_vector_type(8)));
typedef unsigned u32x4 __attribute__((ext_vector_type(4)));
typedef unsigned u32x2 __attribute__((ext_vector_type(2)));
constexpr int NWAVES = 8, NTHR = 512;
constexpr int D = 1024, NB = 8, SEQ = 2048, CTXL = 256, MX = NB * SEQ, MC = NB * CTXL, MT = MX + MC;
constexpr int NIN = 2304, INW = 2320, FF = 2816;
constexpr int C_AQ = 0, C_AK = 512, C_AV = 640, C_MQ = 768, C_MK = 1024, C_MV = 1280, C_MO = 1792;
constexpr int NCH = 36;
constexpr int STSZ = 8256;
constexpr float EPSF = 1e-6f;
constexpr size_t MiB = 1u << 20;
constexpr size_t WS_MOD = 1 * MiB;
constexpr size_t WS_ROPE = 1 * MiB + 512 * 1024;
constexpr size_t WS_WIN = 2 * MiB, WS_WOUT = 7 * MiB, WS_WFI = 9 * MiB, WS_WFO = 20 * MiB;
constexpr size_t WS_GATES = 26 * MiB;
constexpr size_t WS_SCAL = 28 * MiB;
constexpr size_t WS_A = 30 * MiB;
constexpr size_t WS_PX = 66 * MiB;
constexpr size_t WS_QKS = 147 * MiB;
constexpr size_t WS_ST = 165 * MiB;
constexpr size_t WS_STN = 202 * MiB;
constexpr size_t WS_CP = 203 * MiB;
constexpr size_t WS_NP = 240 * MiB;
constexpr size_t WS_MIX = 66 * MiB;
constexpr size_t WS_H = 100 * MiB;
constexpr size_t WS_FX = 190 * MiB;
constexpr int LDS_BYTES = 139264;
constexpr int CW_MODCNT = 3712;

struct Args {
    const float *x, *c, *ctx, *c_ctx, *w_ada, *b_ada, *g_pre_mix, *w_in, *w_conv, *b_gates, *sink, *g_ml, *w_out, *g_post_mix, *g_pre_ffn, *w_ffi, *w_ffo, *g_post_ffn;
    float* out; unsigned char* ws; int ph_lo, ph_hi;
};

__device__ __forceinline__ unsigned f2bf(float f) { unsigned u = __builtin_bit_cast(unsigned, f); return (u + 0x7fffu + ((u >> 16) & 1u)) >> 16; }
__device__ __forceinline__ unsigned pk2(float lo, float hi) { return f2bf(lo) | (f2bf(hi) << 16); }
__device__ __forceinline__ float bf2f(unsigned h) { return __builtin_bit_cast(float, h << 16); }
__device__ __forceinline__ float bflo(unsigned w) { return __builtin_bit_cast(float, w << 16); }
__device__ __forceinline__ float bfhi(unsigned w) { return __builtin_bit_cast(float, w & 0xffff0000u); }

template <int CTRL> __device__ __forceinline__ float dpp_f(float v) { return __builtin_bit_cast(float, __builtin_amdgcn_update_dpp(0, __builtin_bit_cast(int, v), CTRL, 0xF, 0xF, true)); }
__device__ __forceinline__ float red16_sum(float v) { v += dpp_f<0xB1>(v); v += dpp_f<0x4E>(v); v += dpp_f<0x141>(v); v += dpp_f<0x140>(v); return v; }
__device__ __forceinline__ float red16_max(float v) { v = fmaxf(v, dpp_f<0xB1>(v)); v = fmaxf(v, dpp_f<0x4E>(v)); v = fmaxf(v, dpp_f<0x141>(v)); v = fmaxf(v, dpp_f<0x140>(v)); return v; }
__device__ __forceinline__ float wave_sum(float v) { v = red16_sum(v); v += __shfl_xor(v, 16); v += __shfl_xor(v, 32); return v; }
__device__ __forceinline__ float wave_max(float v) { v = red16_max(v); v = fmaxf(v, __shfl_xor(v, 16)); v = fmaxf(v, __shfl_xor(v, 32)); return v; }
__device__ __forceinline__ float fexp(float x) { return __builtin_amdgcn_exp2f(x * 1.44269504089f); }
__device__ __forceinline__ float frcp(float x) { return __builtin_amdgcn_rcpf(x); }
__device__ __forceinline__ float scan_sum_up(float v, int lane) {
#pragma unroll
    for (int o = 1; o < 64; o <<= 1) { const float t = __shfl_up(v, o); if (lane >= o) v += t; }
    return v;
}
__device__ __forceinline__ float scan_max_up(float v, int lane) {
#pragma unroll
    for (int o = 1; o < 64; o <<= 1) { const float t = __shfl_up(v, o); if (lane >= o) v = fmaxf(v, t); }
    return v;
}
__device__ __forceinline__ float scan_sum_down(float v, int lane) {
#pragma unroll
    for (int o = 1; o < 64; o <<= 1) { const float t = __shfl_down(v, o); if (lane + o < 64) v += t; }
    return v;
}
__device__ __forceinline__ float scan_max_down(float v, int lane) {
#pragma unroll
    for (int o = 1; o < 64; o <<= 1) { const float t = __shfl_down(v, o); if (lane + o < 64) v = fmaxf(v, t); }
    return v;
}
__device__ __forceinline__ float logsig(float f) { return fminf(f, 0.f) - log1pf(expf(-fabsf(f))); }
__device__ __forceinline__ f32x4 mfma16(bf16x8 a, bf16x8 b, f32x4 c) { return __builtin_amdgcn_mfma_f32_16x16x32_bf16(a, b, c, 0, 0, 0); }
#define LDS_WAIT() asm volatile("s_waitcnt lgkmcnt(0)" ::: "memory")
typedef short v4i16_t __attribute__((ext_vector_type(4)));
__device__ __forceinline__ u32x2 tr4(const LAS bf16* blk, int stride, int lane) { const int li = lane & 15;
    const v4i16_t v = __builtin_amdgcn_ds_read_tr16_b64_v4i16((LAS v4i16_t*)(blk + (li >> 2) * stride + (li & 3) * 4)); return __builtin_bit_cast(u32x2, v); }
__device__ __forceinline__ bf16x8 tr8(const LAS bf16* blk_lo, const LAS bf16* blk_hi, int stride, int lane) { const u32x2 lo = tr4(blk_lo, stride, lane), hi = tr4(blk_hi, stride, lane);
    u32x4 w; w.x = lo.x; w.y = lo.y; w.z = hi.x; w.w = hi.y; return __builtin_bit_cast(bf16x8, w); }
typedef __bf16 bf16x2_t __attribute__((ext_vector_type(2)));
__device__ __forceinline__ unsigned cvtpk(float lo, float hi) { const f32x2 v = {lo, hi}; const bf16x2_t b = __builtin_convertvector(v, bf16x2_t); return __builtin_bit_cast(unsigned, b); }

__device__ __forceinline__ void transpose_item(const float* W, int ldw, int K, bf16* WT, int dst_row0, int k0, int n0, LAS float* scr, int lane, int nvalid = 32) {
    const int cc = (lane & 31) < nvalid ? (lane & 31) : nvalid - 1;
    float tv[32];
#pragma unroll
    for (int i = 0; i < 32; ++i) { const int kk = 2 * i + (lane >> 5); tv[i] = __builtin_nontemporal_load(W + (size_t)(k0 + kk) * ldw + n0 + cc); }
#pragma unroll
    for (int i = 0; i < 32; ++i) { const int kk = 2 * i + (lane >> 5); scr[kk * 33 + (lane & 31)] = tv[i]; }
    LDS_WAIT(); asm volatile("" ::: "memory");
    const int c = lane & 7;
#pragma unroll
    for (int j = 0; j < 4; ++j) { const int n = (lane >> 3) + 8 * j; const LAS float* s = scr + (8 * c) * 33 + n;
        u32x4 o; o.x = pk2(s[0 * 33], s[1 * 33]); o.y = pk2(s[2 * 33], s[3 * 33]); o.z = pk2(s[4 * 33], s[5 * 33]); o.w = pk2(s[6 * 33], s[7 * 33]);
        *(u32x4*)(WT + (size_t)(dst_row0 + n) * K + k0 + 8 * c) = o; }
    LDS_WAIT(); asm volatile("" ::: "memory");
}

__device__ __forceinline__ void mod_item(const Args& a, LAS unsigned char* lds, int it, int tid, int lane, int wave) {
    float* mod = (float*)(a.ws + WS_MOD);
        LAS float* sv = (LAS float*)lds;
        LAS float* red = (LAS float*)(lds + 40960);
        for (int i = tid; i < 9 * 1024; i += NTHR) { const int r = i >> 10, k = i & 1023; const float cv = r < 8 ? a.c[r * 1024 + k] : a.c_ctx[k]; sv[i] = cv / (1.0f + expf(-cv)); }
        __syncthreads();
        const int cq = tid & 15, kg = tid >> 4, j0 = it * 64;
        f32x4 acc[9];
#pragma unroll
        for (int r = 0; r < 9; ++r) acc[r] = (f32x4){0.f, 0.f, 0.f, 0.f};
        for (int k0 = 0; k0 < 32; k0 += 16) { f32x4 wv[16];
#pragma unroll
            for (int kk = 0; kk < 16; ++kk) wv[kk] = __builtin_nontemporal_load((const f32x4*)(a.w_ada + (size_t)(kg * 32 + k0 + kk) * 6144 + j0 + cq * 4));
#pragma unroll
            for (int kk = 0; kk < 16; ++kk) { const int k = kg * 32 + k0 + kk;
#pragma unroll
                for (int r = 0; r < 9; ++r) acc[r] += sv[r * 1024 + k] * wv[kk]; } }
#pragma unroll
        for (int r = 0; r < 9; ++r)
#pragma unroll
            for (int e = 0; e < 4; ++e) { float v = acc[r][e]; v += __shfl_xor(v, 16); v += __shfl_xor(v, 32); acc[r][e] = v; }
        if (lane < 16) {
#pragma unroll
            for (int r = 0; r < 9; ++r)
#pragma unroll
                for (int e = 0; e < 4; ++e) red[(wave * 9 + r) * 64 + cq * 4 + e] = acc[r][e];
        }
        __syncthreads();
        for (int i = tid; i < 9 * 64; i += NTHR) { const int r = i >> 6, col = i & 63; float s = a.b_ada[j0 + col];
#pragma unroll
            for (int w = 0; w < 8; ++w) s += red[(w * 9 + r) * 64 + col];
            mod[r * 6144 + j0 + col] = s; }
        __syncthreads();
    }

constexpr int TI_IN = 16 * 73, TI_OUT = 16 * 32, TI_FI = 16 * 176, TI_FO = 44 * 32;
__device__ __forceinline__ void transpose_items(const Args& a, LAS unsigned char* lds, int lo, int hi, int worker, int nworkers, int wave, int lane) {
    unsigned char* ws = a.ws; LAS float* scr = (LAS float*)(lds + wave * 8448);
    for (int it = lo + worker; it < hi; it += nworkers) {
        int r = it;
        if (r < TI_IN) { const int kb = r / 73, nb = r % 73; transpose_item(a.w_in, INW, D, (bf16*)(ws + WS_WIN), 32 * nb, 64 * kb, 32 * nb, scr, lane, nb == 72 ? 16 : 32); continue; } r -= TI_IN;
        if (r < TI_OUT) { const int kb = r / 32, nb = r % 32; transpose_item(a.w_out, D, D, (bf16*)(ws + WS_WOUT), 32 * nb, 64 * kb, 32 * nb, scr, lane); continue; } r -= TI_OUT;
        if (r < TI_FI) { const int kb = r / 176, nb = r % 176; const int n0 = 32 * nb, bj = n0 >= FF ? 1 : 0, jj = n0 - bj * FF; const int dst = 256 * (jj >> 7) + 128 * bj + (jj & 127);
            transpose_item(a.w_ffi, 2 * FF, D, (bf16*)(ws + WS_WFI), dst, 64 * kb, n0, scr, lane); continue; } r -= TI_FI;
        { const int kb = r / 32, nb = r % 32; transpose_item(a.w_ffo, D, FF, (bf16*)(ws + WS_WFO), 32 * nb, 64 * kb, 32 * nb, scr, lane); }
    }
}
__device__ __forceinline__ void transpose_by_idle(const Args& a, LAS unsigned char* lds, int lo, int hi, int first, int G, int wave, int lane) {
    if (first <= 0 || first >= G) transpose_items(a, lds, lo, hi, blockIdx.x * NWAVES + wave, G * NWAVES, wave, lane);
    else if ((int)blockIdx.x >= first) transpose_items(a, lds, lo, hi, ((int)blockIdx.x - first) * NWAVES + wave, (G - first) * NWAVES, wave, lane);
}

__device__ __forceinline__ void phase0(const Args& a, LAS unsigned char* lds, int tid, int lane, int wave, int G) {
    unsigned char* ws = a.ws;
    float* mod = (float*)(ws + WS_MOD);
    { float* rope = (float*)(ws + WS_ROPE);
      for (int i = blockIdx.x * NTHR + tid; i < 96 * 16; i += G * NTHR) { const int pos = i >> 4, f = i & 15; const float inv = powf(10000.0f, -(float)f / 16.0f);
          const float ang = (float)(pos < 32 ? pos : pos - 32) * inv; rope[2 * i] = cosf(ang); rope[2 * i + 1] = sinf(ang); } }
    for (int it = G - 1 - (int)blockIdx.x; it < 32; it += G) { mod_item(a, lds, it, tid, lane, wave);
        asm volatile("s_waitcnt vmcnt(0)" ::: "memory"); __syncthreads();
        if (tid == 0) { __builtin_amdgcn_fence(__ATOMIC_RELEASE, "agent"); asm volatile("s_waitcnt vmcnt(0)" ::: "memory");
            (void)__hip_atomic_fetch_add((unsigned*)a.ws + CW_MODCNT, 1u, __ATOMIC_RELAXED, __HIP_MEMORY_SCOPE_AGENT); } }
    transpose_items(a, lds, 0, TI_IN, blockIdx.x * NWAVES + wave, G * NWAVES, wave, lane);
}

__device__ __forceinline__ void phase1(const Args& a, LAS unsigned char* lds, int tid, int lane, int wave, int G) {
    unsigned char* ws = a.ws; const float* mod = (const float*)(ws + WS_MOD);
    bf16* A = (bf16*)(ws + WS_A);
    const int gw = blockIdx.x * NWAVES + wave, NGW = G * NWAVES;
    f32x4 nxa[4], nxb[4];
#define P1_LOAD(dst_, row_) do { const int r_ = (row_); if (r_ < MT) { const float* xr_ = r_ < MX ? a.x + (size_t)r_ * D : a.ctx + (size_t)(r_ - MX) * D; \
        _Pragma("unroll") for (int j_ = 0; j_ < 4; ++j_) dst_[j_] = __builtin_nontemporal_load((const f32x4*)xr_ + lane + 64 * j_); } } while (0)
    P1_LOAD(nxa, gw); P1_LOAD(nxb, gw + NGW);
    if (tid == 0) { unsigned sp = 0u; while (__hip_atomic_load((unsigned*)a.ws + CW_MODCNT, __ATOMIC_RELAXED, __HIP_MEMORY_SCOPE_AGENT) < 32u && ++sp < (1u << 22)) __builtin_amdgcn_s_sleep(1);
        __builtin_amdgcn_fence(__ATOMIC_ACQUIRE, "agent"); asm volatile("s_waitcnt vmcnt(0)" ::: "memory"); }
    __syncthreads();
    for (int row = gw; row < MT; row += NGW) {
        const float* mrow = mod + (row < MX ? (row >> 11) : 8) * 6144;
        f32x4 v[4]; float ss = 0.f;
#pragma unroll
        for (int j = 0; j < 4; ++j) { v[j] = nxa[j]; nxa[j] = nxb[j]; ss += (v[j].x * v[j].x + v[j].y * v[j].y) + (v[j].z * v[j].z + v[j].w * v[j].w); }
        P1_LOAD(nxb, row + 2 * NGW);
        const float rstd = rsqrtf(wave_sum(ss) * (1.0f / D) + EPSF);
#pragma unroll
        for (int j = 0; j < 4; ++j) { const int k = 4 * lane + 256 * j;
            const f32x4 g = *(const f32x4*)(a.g_pre_mix + k), sh = *(const f32x4*)(mrow + k), sc = *(const f32x4*)(mrow + 1024 + k);
            v[j] = (v[j] * rstd * g) * (1.0f + sc) + sh;
            u32x2 o; o.x = cvtpk(v[j].x, v[j].y); o.y = cvtpk(v[j].z, v[j].w);
            *(u32x2*)(A + (size_t)row * D + k) = o; }
    }
#undef P1_LOAD
}

constexpr int ATT_KV_OFF = 36864, ATT_ROPE_OFF = 73728;
__device__ __forceinline__ void attn_stage_rope(const Args& a, LAS unsigned char* lds, int tid) {
    const float* rope = (const float*)(a.ws + WS_ROPE); LAS float* rl = (LAS float*)(lds + ATT_ROPE_OFF);
    for (int i = tid; i < 96 * 32; i += NTHR) rl[i] = rope[i];
}
__device__ __forceinline__ void attn_unit(const Args& a, LAS unsigned char* lds, int unit, int tid, int lane, int wave) {
    unsigned char* ws = a.ws; const bf16* px = (const bf16*)(ws + WS_PX); bf16* mixcat = (bf16*)(ws + WS_A);
    const int hp = unit & 1, qb = (unit >> 1) & 15, hk = (unit >> 5) & 1, b = unit >> 6;
    LAS bf16* Qs = (LAS bf16*)lds;
    const LAS float* rl = (const LAS float*)(lds + ATT_ROPE_OFF);
    const int fr = lane & 15, fq = lane >> 4;
    constexpr float QSCALE = 0.125f * 1.44269504089f;
    const int tfirst = (qb == 0) ? 2 : 0;
    u32x4 kw1, kw2, vw;
#define ATT_NEXT(t_) (((t_) + 1 < 6 && (qb * 2 - 2 + (t_) + 1) >= 32) ? 6 : (t_) + 1)
#define ATT_PREFETCH(tile_) do { const int t_ = (tile_); const bool lat_ = t_ < 6; \
        const size_t kr_ = lat_ ? (size_t)(b * SEQ + (qb * 2 - 2 + t_) * 64) : (size_t)(MX + b * CTXL + (t_ - 6) * 64); \
        if (lat_) { if (tid < 256) { const int key = tid >> 2, part = tid & 3; const bf16* src = px + (kr_ + key) * NIN + C_AK + hk * 64 + (part >> 1) * 32 + (part & 1) * 8; kw1 = *(const u32x4*)src; kw2 = *(const u32x4*)(src + 16); } } \
        else { kw1 = *(const u32x4*)(px + (kr_ + (tid >> 3)) * NIN + C_AK + hk * 64 + (tid & 7) * 8); } \
        vw = *(const u32x4*)(px + (kr_ + (tid >> 3)) * NIN + C_AV + hk * 64 + (tid & 7) * 8); } while (0)
#define ATT_WRITE(buf_, tile_) do { const int t_ = (tile_); LAS bf16* Kb_ = (LAS bf16*)(lds + ATT_KV_OFF + (buf_) * 18432); LAS bf16* Vb_ = Kb_ + 4608; \
        if (t_ < 6) { if (tid < 256) { const int key = tid >> 2, part = tid & 3, half = part >> 1, sub = (part & 1) * 8; const int pos = (qb * 2 - 2 + t_) * 64 + key; \
                const LAS float* tb = rl + ((half == 0 ? (pos >> 6) : 32 + (pos & 63)) * 16 + sub) * 2; u32x4 o1, o2; \
                _Pragma("unroll") for (int i = 0; i < 4; ++i) { const f32x4 cs = *(const LAS f32x4*)(tb + 4 * i); \
                    const float u1a = bflo(kw1[i]), u1b = bfhi(kw1[i]), u2a = bflo(kw2[i]), u2b = bfhi(kw2[i]); \
                    o1[i] = cvtpk(u1a * cs.x - u2a * cs.y, u1b * cs.z - u2b * cs.w); o2[i] = cvtpk(u2a * cs.x + u1a * cs.y, u2b * cs.z + u1b * cs.w); } \
                *(LAS u32x4*)(Kb_ + key * 72 + half * 32 + sub) = o1; *(LAS u32x4*)(Kb_ + key * 72 + half * 32 + 16 + sub) = o2; } } \
        else { *(LAS u32x4*)(Kb_ + (tid >> 3) * 72 + (tid & 7) * 8) = kw1; } \
        *(LAS u32x4*)(Vb_ + (tid >> 3) * 72 + (tid & 7) * 8) = vw; } while (0)
    ATT_PREFETCH(tfirst);
    __syncthreads();
#pragma unroll
    for (int tt = 0; tt < 2; ++tt) { const int task = tid + tt * NTHR; const int r = task >> 2, part = task & 3, half = part >> 1, sub = (part & 1) * 8;
        const int pos = qb * 128 + (r & 127), head = hk * 4 + hp * 2 + (r >> 7);
        const bf16* src = px + (size_t)(b * SEQ + pos) * NIN + C_AQ + head * 64 + half * 32 + sub;
        const u32x4 w1 = *(const u32x4*)src, w2 = *(const u32x4*)(src + 16);
        const LAS float* tb = rl + ((half == 0 ? (pos >> 6) : 32 + (pos & 63)) * 16 + sub) * 2;
        u32x4 o1, o2;
#pragma unroll
        for (int i = 0; i < 4; ++i) { const f32x4 cs = *(const LAS f32x4*)(tb + 4 * i) * QSCALE;
            const float u1a = bflo(w1[i]), u1b = bfhi(w1[i]), u2a = bflo(w2[i]), u2b = bfhi(w2[i]);
            o1[i] = cvtpk(u1a * cs.x - u2a * cs.y, u1b * cs.z - u2b * cs.w); o2[i] = cvtpk(u2a * cs.x + u1a * cs.y, u2b * cs.z + u1b * cs.w); }
        *(LAS u32x4*)(Qs + r * 72 + half * 32 + sub) = o1; *(LAS u32x4*)(Qs + r * 72 + half * 32 + 16 + sub) = o2; }
    ATT_WRITE(0, tfirst);
    { const int t1 = ATT_NEXT(tfirst); if (t1 < 10) ATT_PREFETCH(t1); }
    __syncthreads();
    bf16x8 qf[2][2];
#pragma unroll
    for (int rt = 0; rt < 2; ++rt)
#pragma unroll
        for (int kk = 0; kk < 2; ++kk) qf[rt][kk] = *(const LAS bf16x8*)(Qs + (wave * 32 + rt * 16 + fr) * 72 + kk * 32 + fq * 8);
    const int head = hk * 4 + hp * 2 + (wave >> 2);
    const float sinkv = a.sink[head] * 1.44269504089f;
    float mrun[2], lrun[2]; f32x4 OT[2][4];
#pragma unroll
    for (int rt = 0; rt < 2; ++rt) { mrun[rt] = sinkv; lrun[rt] = (fq == 0) ? 1.0f : 0.0f;
#pragma unroll
        for (int dt = 0; dt < 4; ++dt) OT[rt][dt] = (f32x4){0.f, 0.f, 0.f, 0.f}; }
    const int qbase = qb * 128 + (wave & 3) * 32;
    int cur = 0;
    for (int tile = tfirst; tile < 10; ) {
        const bool lat = tile < 6; const int key0 = (qb * 2 - 2 + tile) * 64;
        const int nxt = ATT_NEXT(tile);
        if (nxt < 10) { ATT_WRITE(cur ^ 1, nxt); const int n2 = ATT_NEXT(nxt); if (n2 < 10) ATT_PREFETCH(n2); }
        const LAS bf16* Ks = (const LAS bf16*)(lds + ATT_KV_OFF + cur * 18432); const LAS bf16* Vn = Ks + 4608;
        f32x4 sc[2][4];
#pragma unroll
        for (int kt4 = 0; kt4 < 4; ++kt4) { const bf16x8 kf0 = *(const LAS bf16x8*)(Ks + (kt4 * 16 + fr) * 72 + fq * 8), kf1 = *(const LAS bf16x8*)(Ks + (kt4 * 16 + fr) * 72 + 32 + fq * 8);
#pragma unroll
            for (int rt = 0; rt < 2; ++rt) { f32x4 acc = mfma16(kf0, qf[rt][0], (f32x4){0.f, 0.f, 0.f, 0.f}); sc[rt][kt4] = mfma16(kf1, qf[rt][1], acc); } }
        const bool need_mask = lat && (tile <= 1 || tile >= 4);
        bf16x8 pf[2][2];
#pragma unroll
        for (int rt = 0; rt < 2; ++rt) {
            if (need_mask) { const int qpos = qbase + rt * 16 + fr;
#pragma unroll
                for (int kt4 = 0; kt4 < 4; ++kt4)
#pragma unroll
                    for (int j = 0; j < 4; ++j) { const int dpos = qpos - (key0 + kt4 * 16 + fq * 4 + j); if (dpos > 128 || dpos < -128) sc[rt][kt4][j] = -INFINITY; } }
            float mx = -INFINITY;
#pragma unroll
            for (int kt4 = 0; kt4 < 4; ++kt4) mx = fmaxf(mx, fmaxf(fmaxf(sc[rt][kt4][0], sc[rt][kt4][1]), fmaxf(sc[rt][kt4][2], sc[rt][kt4][3])));
            mx = fmaxf(mx, __shfl_xor(mx, 16)); mx = fmaxf(mx, __shfl_xor(mx, 32));
            const float mnew = fmaxf(mrun[rt], mx), alpha = __builtin_amdgcn_exp2f(mrun[rt] - mnew); mrun[rt] = mnew;
            f32x4 ps4 = (f32x4){0.f, 0.f, 0.f, 0.f};
#pragma unroll
            for (int kt4 = 0; kt4 < 4; ++kt4) { f32x4 t = sc[rt][kt4] - mnew;
                t[0] = __builtin_amdgcn_exp2f(t[0]); t[1] = __builtin_amdgcn_exp2f(t[1]); t[2] = __builtin_amdgcn_exp2f(t[2]); t[3] = __builtin_amdgcn_exp2f(t[3]);
                ps4 += t; sc[rt][kt4] = t; }
            const float ps = (ps4[0] + ps4[1]) + (ps4[2] + ps4[3]);
            lrun[rt] = lrun[rt] * alpha + ps;
#pragma unroll
            for (int dt = 0; dt < 4; ++dt) OT[rt][dt] *= alpha;
#pragma unroll
            for (int kk = 0; kk < 2; ++kk) { u32x4 w; w.x = cvtpk(sc[rt][2 * kk][0], sc[rt][2 * kk][1]); w.y = cvtpk(sc[rt][2 * kk][2], sc[rt][2 * kk][3]);
                w.z = cvtpk(sc[rt][2 * kk + 1][0], sc[rt][2 * kk + 1][1]); w.w = cvtpk(sc[rt][2 * kk + 1][2], sc[rt][2 * kk + 1][3]); pf[rt][kk] = __builtin_bit_cast(bf16x8, w); }
        }
#pragma unroll
        for (int kk = 0; kk < 2; ++kk)
#pragma unroll
            for (int dt = 0; dt < 4; ++dt) { const bf16x8 vf = tr8(Vn + (kk * 32 + fq * 4) * 72 + dt * 16, Vn + (kk * 32 + 16 + fq * 4) * 72 + dt * 16, 72, lane);
#pragma unroll
                for (int rt = 0; rt < 2; ++rt) OT[rt][dt] = mfma16(vf, pf[rt][kk], OT[rt][dt]); }
        __syncthreads();
        cur ^= 1; tile = nxt;
    }
#undef ATT_PREFETCH
#undef ATT_WRITE
#undef ATT_NEXT
#pragma unroll
    for (int rt = 0; rt < 2; ++rt) { float l = lrun[rt]; l += __shfl_xor(l, 16); l += __shfl_xor(l, 32); const float inv = 1.0f / l; const int qpos = qbase + rt * 16 + fr;
        bf16* orow = mixcat + (size_t)(b * SEQ + qpos) * D + head * 64 + fq * 4;
#pragma unroll
        for (int dt = 0; dt < 4; ++dt) { u32x2 o; o.x = cvtpk(OT[rt][dt][0] * inv, OT[rt][dt][1] * inv); o.y = cvtpk(OT[rt][dt][2] * inv, OT[rt][dt][3] * inv); *(u32x2*)(orow + dt * 16) = o; } }
}

__device__ __forceinline__ void phase3_mllocal(const Args& a, LAS unsigned char* lds, int tid, int lane, int wave, int G) {
    unsigned char* ws = a.ws; const bf16* px = (const bf16*)(ws + WS_PX); const float* gates = (const float*)(ws + WS_GATES);
    bf16* qks = (bf16*)(ws + WS_QKS); float* scal = (float*)(ws + WS_SCAL); bf16* stC = (bf16*)(ws + WS_ST); float* stN = (float*)(ws + WS_STN);
    LAS float* gl = (LAS float*)lds;
    LAS bf16* Kn = (LAS bf16*)(lds + 2048);
    LAS bf16* WV = (LAS bf16*)(lds + 2048 + 9216);
    const int fr = lane & 15, fq = lane >> 4;
    constexpr int NU = NB * NCH * 4;
    u32x4 rc[3][2], rv0, rv1; float rw[3][16]; float rg0 = 0.f, rg1 = 0.f, rg2 = 0.f, rg3 = 0.f;
#define ML3_LOAD(unit_) do { const int u_ = (unit_); const int h_ = u_ & 3, bc_ = u_ >> 2, c36_ = bc_ % NCH, b_ = bc_ / NCH; \
        const int T_ = c36_ < 4 ? CTXL : SEQ, t0_ = c36_ < 4 ? c36_ * 64 : (c36_ - 4) * 64; const size_t rb_ = c36_ < 4 ? (size_t)(MX + b_ * CTXL) : (size_t)(b_ * SEQ); \
        const int s_ = tid >> 3, cg8_ = tid & 7, isk_ = cg8_ >> 2, c0_ = (cg8_ & 3) * 16; const int col_ = (isk_ ? C_MK : C_MQ) + h_ * 64 + c0_, wch_ = isk_ * 256 + h_ * 64 + c0_; \
        _Pragma("unroll") for (int dt_ = 0; dt_ < 3; ++dt_) { const int tt_ = t0_ + s_ + dt_ - 1; \
            if (tt_ >= 0 && tt_ < T_) { const bf16* src_ = px + (rb_ + tt_) * NIN + col_; rc[dt_][0] = *(const u32x4*)src_; rc[dt_][1] = *(const u32x4*)(src_ + 8); } \
            else { rc[dt_][0] = (u32x4){0u, 0u, 0u, 0u}; rc[dt_][1] = (u32x4){0u, 0u, 0u, 0u}; } \
            _Pragma("unroll") for (int i_ = 0; i_ < 4; ++i_) { const f32x4 w_ = *(const f32x4*)(a.w_conv + dt_ * 512 + wch_ + 4 * i_); rw[dt_][4 * i_] = w_.x; rw[dt_][4 * i_ + 1] = w_.y; rw[dt_][4 * i_ + 2] = w_.z; rw[dt_][4 * i_ + 3] = w_.w; } } \
        { const bf16* vs_ = px + (rb_ + t0_ + s_) * NIN + C_MV + h_ * 128 + cg8_ * 16; rv0 = *(const u32x4*)vs_; rv1 = *(const u32x4*)(vs_ + 8); } \
        if (tid < 64) { const float* g_ = gates + (rb_ + t0_ + tid) * 16; rg0 = g_[h_] + a.b_gates[h_]; rg1 = g_[4 + h_] + a.b_gates[4 + h_]; rg2 = g_[8 + h_] + a.b_gates[8 + h_]; rg3 = g_[12 + h_] + a.b_gates[12 + h_]; } } while (0)
    int unit = blockIdx.x;
    if (unit < NU) ML3_LOAD(unit);
    for (; unit < NU; unit += G) {
        const int h = unit & 3, bc = unit >> 2, c36 = bc % NCH, b = bc / NCH;
        const int t0 = c36 < 4 ? c36 * 64 : (c36 - 4) * 64;
        const size_t rowbase = c36 < 4 ? (size_t)(MX + b * CTXL) : (size_t)(b * SEQ);
        const int bhdF = (b * 4 + h) * 2, bhdB = bhdF + 1;
        __syncthreads();
        if (tid < 64) {
            const float lf = logsig(rg1), lb = logsig(rg3);
            const float totf = wave_sum(lf), totb = wave_sum(lb);
            const float sf = totf - scan_sum_up(lf, lane), pb = scan_sum_up(lb, lane) - lb;
            const float gf = sf + rg0, gb = pb + rg2;
            const float mf = wave_max(gf), mb = wave_max(gb);
            gl[256 + tid] = expf(gf - mf); gl[320 + tid] = expf(gb - mb);
            if (tid == 0) { scal[(bhdF * NCH + c36) * 2] = mf; scal[(bhdF * NCH + c36) * 2 + 1] = totf; scal[(bhdB * NCH + c36) * 2] = mb; scal[(bhdB * NCH + c36) * 2 + 1] = totb; } }
        { const int s = tid >> 3, cg8 = tid & 7, isk = cg8 >> 2, c0 = (cg8 & 3) * 16;
          float acc[16];
#pragma unroll
          for (int i = 0; i < 16; ++i) acc[i] = 0.f;
#pragma unroll
          for (int dt = 0; dt < 3; ++dt)
#pragma unroll
              for (int hq = 0; hq < 2; ++hq)
#pragma unroll
                  for (int i = 0; i < 4; ++i) { const unsigned w = rc[dt][hq][i]; acc[hq * 8 + 2 * i] += rw[dt][hq * 8 + 2 * i] * bflo(w); acc[hq * 8 + 2 * i + 1] += rw[dt][hq * 8 + 2 * i + 1] * bfhi(w); }
          const float qs = isk ? 1.0f : 0.125f;
#pragma unroll
          for (int i = 0; i < 16; ++i) { const float v = acc[i]; acc[i] = qs * v * frcp(1.0f + fexp(-v)); }
          u32x4 o0, o1;
#pragma unroll
          for (int i = 0; i < 4; ++i) { o0[i] = pk2(acc[2 * i], acc[2 * i + 1]); o1[i] = pk2(acc[8 + 2 * i], acc[8 + 2 * i + 1]); }
          bf16* dst = qks + (rowbase + t0 + s) * 512 + isk * 256 + h * 64 + c0; *(u32x4*)dst = o0; *(u32x4*)(dst + 8) = o1;
          if (isk) { *(LAS u32x4*)(Kn + s * 72 + c0) = o0; *(LAS u32x4*)(Kn + s * 72 + c0 + 8) = o1; } }
        __syncthreads();
        { const int s = tid >> 3, vg = tid & 7; const float wf = gl[256 + s], wb = gl[320 + s];
#pragma unroll
          for (int hq = 0; hq < 2; ++hq) { const u32x4 w = hq ? rv1 : rv0; u32x4 of, ob;
#pragma unroll
              for (int i = 0; i < 4; ++i) { const float v0 = bflo(w[i]), v1 = bfhi(w[i]); of[i] = cvtpk(v0 * wf, v1 * wf); ob[i] = cvtpk(v0 * wb, v1 * wb); }
              *(LAS u32x4*)(WV + s * 136 + vg * 16 + hq * 8) = of; *(LAS u32x4*)(WV + (64 + s) * 136 + vg * 16 + hq * 8) = ob; } }
        __syncthreads();
        if (unit + G < NU) ML3_LOAD(unit + G);
#pragma unroll
        for (int dir = 0; dir < 2; ++dir) { bf16* dst = stC + ((size_t)((bhdF + dir) * NCH + c36)) * 8192;
            const LAS bf16* wvb = WV + dir * 64 * 136 + wave * 16;
            const bf16x8 av0 = tr8(wvb + (fq * 8) * 136, wvb + (fq * 8 + 4) * 136, 136, lane), av1 = tr8(wvb + (32 + fq * 8) * 136, wvb + (32 + fq * 8 + 4) * 136, 136, lane);
#pragma unroll
            for (int dt = 0; dt < 4; ++dt) { f32x4 acc = mfma16(tr8(Kn + (fq * 8) * 72 + dt * 16, Kn + (fq * 8 + 4) * 72 + dt * 16, 72, lane), av0, (f32x4){0.f, 0.f, 0.f, 0.f});
                acc = mfma16(tr8(Kn + (32 + fq * 8) * 72 + dt * 16, Kn + (32 + fq * 8 + 4) * 72 + dt * 16, 72, lane), av1, acc);
                u32x2 o; o.x = cvtpk(acc[0], acc[1]); o.y = cvtpk(acc[2], acc[3]);
                __builtin_nontemporal_store(o, (u32x2*)(dst + (wave * 16 + fr) * 64 + dt * 16 + fq * 4)); } }
        { const int d = tid >> 3, part = tid & 7; float sF = 0.f, sB = 0.f;
#pragma unroll
          for (int i = 0; i < 8; ++i) { const int u = part * 8 + i; const float kv = bf2f(Kn[u * 72 + d]); sF += gl[256 + u] * kv; sB += gl[320 + u] * kv; }
          sF += __shfl_xor(sF, 1); sF += __shfl_xor(sF, 2); sF += __shfl_xor(sF, 4); sB += __shfl_xor(sB, 1); sB += __shfl_xor(sB, 2); sB += __shfl_xor(sB, 4);
          if (part == 0) { stN[(size_t)(bhdF * NCH + c36) * 64 + d] = sF; stN[(size_t)(bhdB * NCH + c36) * 64 + d] = sB; } }
    }
#undef ML3_LOAD
}

__device__ __forceinline__ void phase4(const Args& a, int tid, int G) {
    unsigned char* ws = a.ws; const bf16* stC = (const bf16*)(ws + WS_ST); const float* stN = (const float*)(ws + WS_STN); const float* scal = (const float*)(ws + WS_SCAL); float* mprev = (float*)(ws + WS_SCAL + 65536);
    bf16* cpC = (bf16*)(ws + WS_CP); float* cpN = (float*)(ws + WS_NP);
    for (int idx = blockIdx.x * NTHR + tid; idx < 64 * 2048; idx += G * NTHR) { const int bhd = idx >> 11, e = idx & 2047, dir = bhd & 1; const bool hasn = e < 16;
        float m = 0.f; f32x4 C = (f32x4){0.f, 0.f, 0.f, 0.f}, N = C;
        for (int s0 = 0; s0 < NCH; s0 += 12) { u32x2 dd[12]; f32x4 dn[12]; float ml[12], bl[12];
#pragma unroll
            for (int i = 0; i < 12; ++i) { const int step = s0 + i; const int c36 = dir == 0 ? step : (step < 4 ? 3 - step : 39 - step); const size_t en = (size_t)(bhd * NCH + c36);
                dd[i] = __builtin_nontemporal_load((const u32x2*)(stC + en * 8192 + e * 4)); ml[i] = scal[en * 2]; bl[i] = scal[en * 2 + 1];
                dn[i] = hasn ? *(const f32x4*)(stN + en * 64 + e * 4) : (f32x4){0.f, 0.f, 0.f, 0.f}; }
#pragma unroll
            for (int i = 0; i < 12; ++i) { const int step = s0 + i; const int c36 = dir == 0 ? step : (step < 4 ? 3 - step : 39 - step); const size_t en = (size_t)(bhd * NCH + c36);
                if (c36 >= 4) { u32x2 o; o.x = cvtpk(C.x, C.y); o.y = cvtpk(C.z, C.w); __builtin_nontemporal_store(o, (u32x2*)(cpC + en * 8192 + e * 4));
                    if (hasn) *(f32x4*)(cpN + en * 64 + e * 4) = N; if (e == 0) mprev[en] = m; }
                const float mn = fmaxf(bl[i] + m, ml[i]); const float dec = expf(bl[i] + m - mn), sc = expf(ml[i] - mn);
                const f32x4 d0 = (f32x4){bflo(dd[i].x), bfhi(dd[i].x), bflo(dd[i].y), bfhi(dd[i].y)};
                C = dec * C + sc * d0; N = dec * N + sc * dn[i]; m = mn; } } }
}

__device__ __forceinline__ void phase5(const Args& a, LAS unsigned char* lds, int tid, int lane, int wave, int G) {
    unsigned char* ws = a.ws; const bf16* px = (const bf16*)(ws + WS_PX); const float* gates = (const float*)(ws + WS_GATES);
    const bf16* qks = (const bf16*)(ws + WS_QKS); const bf16* stC = (const bf16*)(ws + WS_CP); const float* stN = (const float*)(ws + WS_NP);
    const float* mprev = (const float*)(ws + WS_SCAL + 65536); bf16* mixcat = (bf16*)(ws + WS_A);
    LAS float* gl = (LAS float*)lds;
    LAS bf16* Qs = (LAS bf16*)(lds + 8192);
    LAS bf16* Ks = (LAS bf16*)(lds + 8192 + 9216);
    LAS bf16* Vn = (LAS bf16*)(lds + 8192 + 18432);
    LAS bf16* CF = (LAS bf16*)(lds + 8192 + 36864);
    LAS bf16* CB = (LAS bf16*)(lds + 8192 + 55296);
    LAS bf16* SF = (LAS bf16*)(lds + 8192 + 73728);
    LAS bf16* SB = (LAS bf16*)(lds + 8192 + 82944);
    enum { ROWF = 256, ROWB = 320, CCF = 384, CCB = 448, WIF = 512, WIB = 576, LOWF = 640, LOWB = 704, NF = 768, NBK = 832, QNF = 896, QNB = 960, RSP = 1024, SSQ = 1536 };
    const int fr = lane & 15, fq = lane >> 4;
    constexpr int NU = NB * 32 * 4;
    u32x4 rq, rk, rv0, rv1, rcf0, rcf1, rcb0, rcb1; float rgi = 0.f, rgf = 0.f, rn = 0.f, rmpF = 0.f, rmpB = 0.f;
#define ML5_LOAD(unit_) do { const int u_ = (unit_); const int h_ = u_ & 3, bc_ = u_ >> 2, c_ = bc_ & 31, b_ = bc_ >> 5; const size_t row0_ = (size_t)(b_ * SEQ + c_ * 64); const int bhd_ = (b_ * 4 + h_) * 2; \
        const size_t eF_ = (size_t)(bhd_ * NCH + c_ + 4), eB_ = (size_t)((bhd_ + 1) * NCH + c_ + 4); \
        { const int s_ = tid >> 3, ck_ = tid & 7; const bf16* src_ = qks + (row0_ + s_) * 512 + h_ * 64 + ck_ * 8; rq = __builtin_nontemporal_load((const u32x4*)src_); rk = __builtin_nontemporal_load((const u32x4*)(src_ + 256)); \
          const bf16* vs_ = px + (row0_ + s_) * NIN + C_MV + h_ * 128 + ck_ * 8; rv0 = *(const u32x4*)vs_; rv1 = *(const u32x4*)(vs_ + 64); } \
        { const int v_ = tid >> 2, dq_ = tid & 3; const bf16* sf_ = stC + eF_ * 8192 + v_ * 64 + dq_ * 8; const bf16* sb_ = stC + eB_ * 8192 + v_ * 64 + dq_ * 8; \
          rcf0 = __builtin_nontemporal_load((const u32x4*)sf_); rcf1 = __builtin_nontemporal_load((const u32x4*)(sf_ + 32)); rcb0 = __builtin_nontemporal_load((const u32x4*)sb_); rcb1 = __builtin_nontemporal_load((const u32x4*)(sb_ + 32)); } \
        if (tid < 128) { const int t_ = tid & 63, db_ = tid >> 6; const float* g_ = gates + (row0_ + t_) * 16; rgf = g_[(db_ ? 12 : 4) + h_] + a.b_gates[(db_ ? 12 : 4) + h_]; rgi = g_[(db_ ? 8 : 0) + h_] + a.b_gates[(db_ ? 8 : 0) + h_]; } \
        else if (tid < 256) { const int dir_ = (tid - 128) >> 6, d_ = tid & 63; rn = stN[(dir_ ? eB_ : eF_) * 64 + d_]; } \
        rmpF = mprev[eF_]; rmpB = mprev[eB_]; } while (0)
    int unit = blockIdx.x;
    if (unit < NU) ML5_LOAD(unit);
    for (; unit < NU; unit += G) {
        const int h = unit & 3, bc = unit >> 2, c = bc & 31, b = bc >> 5;
        const size_t row0 = (size_t)(b * SEQ + c * 64);
        __syncthreads();
        if (tid < 64) { const int t = tid;
            const float lf = logsig(rgf), bt = scan_sum_up(lf, lane), ct = rgi - bt, pmax = scan_max_up(ct, lane);
            const float mt = bt + fmaxf(rmpF, pmax); gl[ROWF + t] = bt - mt; gl[CCF + t] = ct; gl[WIF + t] = expf(bt + rmpF - mt); gl[LOWF + t] = expf(-mt); }
        else if (tid < 128) { const int t = tid - 64;
            const float lb = logsig(rgf), bt = scan_sum_down(lb, lane), ct = rgi - bt, pmax = scan_max_down(ct, lane);
            const float mt = bt + fmaxf(rmpB, pmax); gl[ROWB + t] = bt - mt; gl[CCB + t] = ct; gl[WIB + t] = expf(bt + rmpB - mt); gl[LOWB + t] = expf(-mt); }
        else if (tid < 256) { gl[NF + (tid - 128)] = rn; }
        { const int s = tid >> 3, ck = tid & 7;
          *(LAS u32x4*)(Qs + s * 72 + ck * 8) = rq; *(LAS u32x4*)(Ks + s * 72 + ck * 8) = rk;
          *(LAS u32x4*)(Vn + s * 136 + ck * 8) = rv0; *(LAS u32x4*)(Vn + s * 136 + 64 + ck * 8) = rv1; }
        { const int v = tid >> 2, dq = tid & 3;
          *(LAS u32x4*)(CF + v * 72 + dq * 8) = rcf0; *(LAS u32x4*)(CF + v * 72 + 32 + dq * 8) = rcf1; *(LAS u32x4*)(CB + v * 72 + dq * 8) = rcb0; *(LAS u32x4*)(CB + v * 72 + 32 + dq * 8) = rcb1; }
        __syncthreads();
        const int tt = wave & 3, vh = wave >> 2;
        unsigned short mor[4][4];
#pragma unroll
        for (int j = 0; j < 4; ++j)
#pragma unroll
            for (int vt = 0; vt < 4; ++vt) mor[j][vt] = px[(row0 + tt * 16 + fq * 4 + j) * NIN + C_MO + h * 128 + vh * 64 + vt * 16 + fr];
        if (unit + G < NU) ML5_LOAD(unit + G);
        { const int t = tid >> 3, part = tid & 7; const u32x4 qw = *(const LAS u32x4*)(Qs + t * 72 + part * 8); float sF = 0.f, sB = 0.f;
#pragma unroll
          for (int i = 0; i < 4; ++i) { const float q0 = bflo(qw[i]), q1 = bfhi(qw[i]); const int d = part * 8 + 2 * i;
              sF += gl[NF + d] * q0 + gl[NF + d + 1] * q1; sB += gl[NBK + d] * q0 + gl[NBK + d + 1] * q1; }
          sF += __shfl_xor(sF, 1); sF += __shfl_xor(sF, 2); sF += __shfl_xor(sF, 4); sB += __shfl_xor(sB, 1); sB += __shfl_xor(sB, 2); sB += __shfl_xor(sB, 4);
          if (part == 0) { gl[QNF + t] = sF; gl[QNB + t] = sB; } }
        {
#pragma unroll
          for (int q = 0; q < 2; ++q) { const int stl = (wave >> 2) * 2 + q; f32x4 acc = (f32x4){0.f, 0.f, 0.f, 0.f};
#pragma unroll
              for (int kk = 0; kk < 2; ++kk) acc = mfma16(*(const LAS bf16x8*)(Qs + (tt * 16 + fr) * 72 + kk * 32 + fq * 8), *(const LAS bf16x8*)(Ks + (stl * 16 + fr) * 72 + kk * 32 + fq * 8), acc);
              const int s = stl * 16 + fr; const float cf = gl[CCF + s], cb = gl[CCB + s];
#pragma unroll
              for (int j = 0; j < 4; ++j) { const int t = tt * 16 + fq * 4 + j;
                  const float wF = (s <= t) ? fexp(gl[ROWF + t] + cf) : 0.f, wB = (s >= t) ? fexp(gl[ROWB + t] + cb) : 0.f;
                  const float sf = acc[j] * wF, sb = acc[j] * wB;
                  SF[t * 72 + s] = (bf16)f2bf(sf); SB[t * 72 + s] = (bf16)f2bf(sb);
                  const float rf = red16_sum(sf), rb = red16_sum(sb);
                  if (fr == 0) { gl[RSP + t * 4 + stl] = rf; gl[RSP + 256 + t * 4 + stl] = rb; } } } }
        __syncthreads();
        { f32x4 aS[2][4], aI[2][4];
#pragma unroll
          for (int dir = 0; dir < 2; ++dir)
#pragma unroll
              for (int vt = 0; vt < 4; ++vt) { aS[dir][vt] = (f32x4){0.f, 0.f, 0.f, 0.f}; aI[dir][vt] = (f32x4){0.f, 0.f, 0.f, 0.f}; }
#pragma unroll
          for (int kk = 0; kk < 2; ++kk) { const bf16x8 qa = *(const LAS bf16x8*)(Qs + (tt * 16 + fr) * 72 + kk * 32 + fq * 8);
              const bf16x8 sfa = *(const LAS bf16x8*)(SF + (tt * 16 + fr) * 72 + kk * 32 + fq * 8), sba = *(const LAS bf16x8*)(SB + (tt * 16 + fr) * 72 + kk * 32 + fq * 8);
#pragma unroll
              for (int vt = 0; vt < 4; ++vt) { const int vrow = (vh * 64 + vt * 16 + fr) * 72 + kk * 32 + fq * 8;
                  const bf16x8 vb = tr8(Vn + (kk * 32 + fq * 8) * 136 + vh * 64 + vt * 16, Vn + (kk * 32 + fq * 8 + 4) * 136 + vh * 64 + vt * 16, 136, lane);
                  aS[0][vt] = mfma16(sfa, vb, aS[0][vt]); aS[1][vt] = mfma16(sba, vb, aS[1][vt]);
                  aI[0][vt] = mfma16(qa, *(const LAS bf16x8*)(CF + vrow), aI[0][vt]); aI[1][vt] = mfma16(qa, *(const LAS bf16x8*)(CB + vrow), aI[1][vt]); } }
          float hv[4][4];
#pragma unroll
          for (int j = 0; j < 4; ++j) { const int t = tt * 16 + fq * 4 + j;
              const float wiF = gl[WIF + t], wiB = gl[WIB + t];
              const float denF = (gl[RSP + t * 4] + gl[RSP + t * 4 + 1]) + (gl[RSP + t * 4 + 2] + gl[RSP + t * 4 + 3]) + wiF * gl[QNF + t];
              const float denB = (gl[RSP + 256 + t * 4] + gl[RSP + 256 + t * 4 + 1]) + (gl[RSP + 256 + t * 4 + 2] + gl[RSP + 256 + t * 4 + 3]) + wiB * gl[QNB + t];
              const float iF = frcp(fmaxf(fabsf(denF), gl[LOWF + t])), iB = frcp(fmaxf(fabsf(denB), gl[LOWB + t]));
              float ss = 0.f;
#pragma unroll
              for (int vt = 0; vt < 4; ++vt) { const float hval = (aS[0][vt][j] + wiF * aI[0][vt][j]) * iF + (aS[1][vt][j] + wiB * aI[1][vt][j]) * iB; hv[vt][j] = hval; ss += hval * hval; }
              ss = red16_sum(ss);
              if (fr == 0) gl[SSQ + t * 2 + vh] = ss; }
          __syncthreads();
#pragma unroll
          for (int j = 0; j < 4; ++j) { const int t = tt * 16 + fq * 4 + j; const float rms = rsqrtf((gl[SSQ + t * 2] + gl[SSQ + t * 2 + 1]) * (1.0f / 128.0f) + EPSF);
              bf16* orow = mixcat + (row0 + t) * D + 512 + h * 128 + vh * 64 + fr;
#pragma unroll
              for (int vt = 0; vt < 4; ++vt) { const float o = bf2f(mor[j][vt]); const float y = hv[vt][j] * rms * a.g_ml[h * 128 + vh * 64 + vt * 16 + fr];
                  orow[vt * 16] = (bf16)(cvtpk(y * frcp(1.0f + fexp(-o)), 0.f) & 0xffffu); } } }
    }
#undef ML5_LOAD
}

__device__ __forceinline__ void phase7(const Args& a, int lane, int wave, int G) {
    unsigned char* ws = a.ws; const float* mod = (const float*)(ws + WS_MOD); const bf16* mix = (const bf16*)(ws + WS_MIX); bf16* A = (bf16*)(ws + WS_A);
    const int gw = blockIdx.x * NWAVES + wave, NGW = G * NWAVES;
    for (int r0 = gw * 8; r0 < MX; r0 += NGW * 8) { const float* mrow = mod + (r0 >> 11) * 6144;
        f32x4 g1[4], gt[4], g2[4], sh[4], sc[4];
#pragma unroll
        for (int j = 0; j < 4; ++j) { const int k = 4 * lane + 256 * j; g1[j] = *(const f32x4*)(a.g_post_mix + k); gt[j] = *(const f32x4*)(mrow + 2048 + k); g2[j] = *(const f32x4*)(a.g_pre_ffn + k);
            sh[j] = *(const f32x4*)(mrow + 3072 + k); sc[j] = *(const f32x4*)(mrow + 4096 + k) + 1.0f; }
        u32x2 nm[4]; f32x4 nx[4];
#pragma unroll
        for (int j = 0; j < 4; ++j) { nm[j] = __builtin_nontemporal_load((const u32x2*)(mix + (size_t)r0 * D + 4 * lane + 256 * j)); nx[j] = __builtin_nontemporal_load((const f32x4*)(a.x + (size_t)r0 * D + 4 * lane + 256 * j)); }
        for (int row = r0; row < r0 + 8; ++row) {
            f32x4 v[4], xv[4]; float ss = 0.f;
#pragma unroll
            for (int j = 0; j < 4; ++j) { const u32x2 w = nm[j]; xv[j] = nx[j]; v[j] = (f32x4){bflo(w.x), bfhi(w.x), bflo(w.y), bfhi(w.y)};
                ss += (v[j].x * v[j].x + v[j].y * v[j].y) + (v[j].z * v[j].z + v[j].w * v[j].w); }
            if (row + 1 < r0 + 8) {
#pragma unroll
                for (int j = 0; j < 4; ++j) { nm[j] = __builtin_nontemporal_load((const u32x2*)(mix + (size_t)(row + 1) * D + 4 * lane + 256 * j)); nx[j] = __builtin_nontemporal_load((const f32x4*)(a.x + (size_t)(row + 1) * D + 4 * lane + 256 * j)); } }
            const float rstd = rsqrtf(wave_sum(ss) * (1.0f / D) + EPSF);
            float s2 = 0.f;
#pragma unroll
            for (int j = 0; j < 4; ++j) { const int k = 4 * lane + 256 * j;
                v[j] = xv[j] + gt[j] * ((v[j] * rstd) * g1[j]);
                s2 += (v[j].x * v[j].x + v[j].y * v[j].y) + (v[j].z * v[j].z + v[j].w * v[j].w); }
            const float rstd2 = rsqrtf(wave_sum(s2) * (1.0f / D) + EPSF);
#pragma unroll
            for (int j = 0; j < 4; ++j) { const int k = 4 * lane + 256 * j;
                const f32x4 y = ((v[j] * rstd2) * g2[j]) * sc[j] + sh[j]; u32x2 o; o.x = cvtpk(y.x, y.y); o.y = cvtpk(y.z, y.w); *(u32x2*)(A + (size_t)row * D + k) = o; } } }
}
__device__ __forceinline__ void phase10(const Args& a, int lane, int wave, int G) {
    unsigned char* ws = a.ws; const float* mod = (const float*)(ws + WS_MOD); const bf16* fx = (const bf16*)(ws + WS_FX); const bf16* mix = (const bf16*)(ws + WS_MIX);
    const int gw = blockIdx.x * NWAVES + wave, NGW = G * NWAVES;
    for (int r0 = gw * 8; r0 < MX; r0 += NGW * 8) { const float* mrow = mod + (r0 >> 11) * 6144;
        f32x4 g1[4], gt[4], gm[4], gtm[4];
#pragma unroll
        for (int j = 0; j < 4; ++j) { const int k = 4 * lane + 256 * j; g1[j] = *(const f32x4*)(a.g_post_ffn + k); gt[j] = *(const f32x4*)(mrow + 5120 + k);
            gm[j] = *(const f32x4*)(a.g_post_mix + k); gtm[j] = *(const f32x4*)(mrow + 2048 + k); }
        u32x2 nm[4], nq[4]; f32x4 nx[4];
#pragma unroll
        for (int j = 0; j < 4; ++j) { const size_t o = (size_t)r0 * D + 4 * lane + 256 * j; nm[j] = __builtin_nontemporal_load((const u32x2*)(fx + o)); nq[j] = __builtin_nontemporal_load((const u32x2*)(mix + o)); nx[j] = __builtin_nontemporal_load((const f32x4*)(a.x + o)); }
        for (int row = r0; row < r0 + 8; ++row) {
            f32x4 v[4], q[4], xv[4]; float ss = 0.f, sq = 0.f;
#pragma unroll
            for (int j = 0; j < 4; ++j) { const u32x2 w = nm[j], u = nq[j]; xv[j] = nx[j]; v[j] = (f32x4){bflo(w.x), bfhi(w.x), bflo(w.y), bfhi(w.y)}; q[j] = (f32x4){bflo(u.x), bfhi(u.x), bflo(u.y), bfhi(u.y)};
                ss += (v[j].x * v[j].x + v[j].y * v[j].y) + (v[j].z * v[j].z + v[j].w * v[j].w); sq += (q[j].x * q[j].x + q[j].y * q[j].y) + (q[j].z * q[j].z + q[j].w * q[j].w); }
            if (row + 1 < r0 + 8) {
#pragma unroll
                for (int j = 0; j < 4; ++j) { const size_t o = (size_t)(row + 1) * D + 4 * lane + 256 * j; nm[j] = __builtin_nontemporal_load((const u32x2*)(fx + o)); nq[j] = __builtin_nontemporal_load((const u32x2*)(mix + o)); nx[j] = __builtin_nontemporal_load((const f32x4*)(a.x + o)); } }
            const float rstd = rsqrtf(wave_sum(ss) * (1.0f / D) + EPSF), rstdq = rsqrtf(wave_sum(sq) * (1.0f / D) + EPSF);
#pragma unroll
            for (int j = 0; j < 4; ++j) { const int k = 4 * lane + 256 * j;
                const f32x4 x1 = xv[j] + gtm[j] * ((q[j] * rstdq) * gm[j]);
                __builtin_nontemporal_store(x1 + gt[j] * ((v[j] * rstd) * g1[j]), (f32x4*)(a.out + (size_t)row * D + k)); } } }
}

#include <cstdlib>
#include <vector>

#define XB_TMO      128
#define XB_XCNT(j)  (256  + 64 * (j))
#define XB_XSUB(j)  (1280 + 64 * (j))
#define XB_XGEN(j)  (2304 + 64 * (j))
#define XB_TOP      3328
#define XB_TOPGEN   3392
#define XCD_BAR_WORDS 3456
#define XB_SPIN_CAP (1u << 18)
__device__ __forceinline__ unsigned xb_ld(unsigned* p)              { return __hip_atomic_load(p, __ATOMIC_RELAXED, __HIP_MEMORY_SCOPE_AGENT); }
__device__ __forceinline__ unsigned xb_add(unsigned* p, unsigned v) { return __hip_atomic_fetch_add(p, v, __ATOMIC_RELAXED, __HIP_MEMORY_SCOPE_AGENT); }
__device__ __forceinline__ unsigned xb_xcc_id() { return (unsigned)__builtin_amdgcn_s_getreg((3 << 11) | 20) & 0xFu; }
#define XB_SPIN(cond, bar) do { unsigned _sp = 0; while (cond) { __builtin_amdgcn_s_sleep(1); \
    if ((++_sp & 255u) == 0u) { if (xb_ld(&(bar)[XB_TMO])) break; if (_sp > XB_SPIN_CAP) { atomicAdd(&(bar)[XB_TMO], 1u); break; } } } } while (0)

struct XcdBarrier {
    unsigned* bar; unsigned x;
    volatile LAS unsigned* st;
};

__device__ __forceinline__ XcdBarrier xcd_barrier_post(unsigned* bar, volatile LAS unsigned* st) {
    XcdBarrier b; b.bar = bar; b.x = xb_xcc_id(); b.st = st;
    if (threadIdx.x == 0) (void)xb_add(&bar[XB_XCNT(b.x)], 1u);
    return b;
}
__device__ __forceinline__ void xcd_barrier_complete(unsigned* bar, unsigned x, unsigned& nloc, unsigned& nx) {
    const unsigned G = gridDim.x * gridDim.y * gridDim.z;
    unsigned sum, cnt, mine, sp = 0u;
    for (;;) {
        sum = 0u; cnt = 0u; mine = 0u;
#pragma unroll
        for (unsigned j = 0; j < 16; ++j) { const unsigned c = xb_ld(&bar[XB_XCNT(j)]); sum += c; cnt += (c > 0u) ? 1u : 0u; mine = (j == x) ? c : mine; }
        if (sum == G) break;
        __builtin_amdgcn_s_sleep(1);
        if ((++sp & 255u) == 0u) { if (xb_ld(&bar[XB_TMO])) break; if (sp > XB_SPIN_CAP) { atomicAdd(&bar[XB_TMO], 1u); break; } }
    }
    nloc = mine > 0u ? mine : 1u; nx = cnt > 0u ? cnt : 1u;
}

__device__ __forceinline__ void xcd_barrier(const XcdBarrier& b) {
    asm volatile("s_waitcnt vmcnt(0)" ::: "memory");
    __syncthreads();
    if (threadIdx.x == 0) {
        unsigned* bar = b.bar;
        __builtin_amdgcn_s_waitcnt(0);
        unsigned nloc = b.st[0], nx = b.st[1];
        if (nloc == 0u) { xcd_barrier_complete(bar, b.x, nloc, nx); b.st[0] = nloc; b.st[1] = nx; }
        const unsigned old = xb_add(&bar[XB_XSUB(b.x)], 1u);
        const unsigned gen = old / nloc;
        if (old + 1u == (gen + 1u) * nloc) {
            __builtin_amdgcn_fence(__ATOMIC_RELEASE, "agent");
            asm volatile("s_waitcnt vmcnt(0)" ::: "memory");
            const unsigned og = xb_add(&bar[XB_TOP], 1u);
            const unsigned tg = og / nx;
            if (og + 1u == (tg + 1u) * nx) xb_add(&bar[XB_TOPGEN], 1u);
            else XB_SPIN(xb_ld(&bar[XB_TOPGEN]) == tg, bar);
            __builtin_amdgcn_fence(__ATOMIC_ACQUIRE, "agent");
            xb_add(&bar[XB_XGEN(b.x)], 1u);
            asm volatile("s_waitcnt vmcnt(0)" ::: "memory");
        } else {
            XB_SPIN(xb_ld(&bar[XB_XGEN(b.x)]) == gen, bar);
            __builtin_amdgcn_fence(__ATOMIC_ACQUIRE, "agent");
            asm volatile("s_waitcnt vmcnt(0)" ::: "memory");
        }
    }
    __syncthreads();
}

__global__ void __launch_bounds__(NTHR, 2) fwd_kernel(Args a) {
    extern __shared__ __attribute__((aligned(16))) unsigned char lds_raw[];
    LAS unsigned char* lds = (LAS unsigned char*)lds_raw;
    cg::grid_group grid = cg::this_grid();
    const int tid = threadIdx.x, lane = tid & 63, wave = __builtin_amdgcn_readfirstlane(tid >> 6), G = gridDim.x;
    const int lo = a.ph_lo, hi = a.ph_hi;
    unsigned char* ws = a.ws;
#ifndef PHASE_MASK
#define PHASE_MASK 0x7ff
#endif
#define IN(k) (((PHASE_MASK >> (k)) & 1) && lo <= (k) && (k) < hi)
#define SEAM(k) do { if (IN(k) && IN((k) + 1)) { xcd_barrier(xbar); } } while (0)
    if (tid < 4) ((LAS unsigned*)(lds + 131072))[tid] = 0u;
    __syncthreads();
    XcdBarrier xbar = xcd_barrier_post((unsigned*)ws, (volatile LAS unsigned*)(lds + 131072));
    if (lo > 1000) grid.sync();
#ifdef TSA
    unsigned long long tsa = 0, tsb = 0;
#define STAMP(i) do { if ((i) == TSA) tsa = __builtin_amdgcn_s_memrealtime(); if ((i) == TSB) tsb = __builtin_amdgcn_s_memrealtime(); } while (0)
#else
#define STAMP(i) do {} while (0)
#endif
    STAMP(0);
    if (IN(0)) { phase0(a, lds, tid, lane, wave, G); } STAMP(1);
    if (IN(1)) { phase1(a, lds, tid, lane, wave, G); } SEAM(1); STAMP(2);
    if (IN(2)) { __syncthreads(); pg8::Gemm g{(const pg8::bf16_t*)(ws + WS_A), (const pg8::bf16_t*)(ws + WS_WIN), MT, NIN + 256, D}; pg8::StaticOrder S; S.init(MT, NIN + 256, G, (int)blockIdx.x);
        pg8::EpiInProj E{(pg8::bf16_t*)(ws + WS_PX), NIN, (float*)(ws + WS_GATES)}; pg8::gemm_phase<pg8::EpiInProj, pg8::StaticOrder, true, true>(lds, g, S, E);
        __syncthreads(); transpose_by_idle(a, lds, TI_IN, TI_IN + TI_OUT, (72 * 10) % G, G, wave, lane);
        { const int first = (72 * 10) % G;
          __syncthreads();
          if (first <= 0 || first >= G) { for (int it = 32 + (int)blockIdx.x; it < 96; it += G) mod_item(a, lds, it, tid, lane, wave); }
          else { const int n2 = (G - first) < 64 ? (G - first) : 64, j = (int)blockIdx.x - first; if (j >= 0 && j < n2) mod_item(a, lds, 32 + j, tid, lane, wave); } } } SEAM(2); STAMP(3);
    if (IN(3)) { __syncthreads(); attn_stage_rope(a, lds, tid); if (G == 256) { for (int i = 0; i < 2; ++i) attn_unit(a, lds, (((int)blockIdx.x & 7) * 2 + i) * 32 + ((int)blockIdx.x >> 3), tid, lane, wave); }
        else { for (int u = blockIdx.x; u < 512; u += G) attn_unit(a, lds, u, tid, lane, wave); }
        STAMP(12);
        phase3_mllocal(a, lds, tid, lane, wave, G); } STAMP(13); SEAM(3); STAMP(4);
    if (IN(4)) { phase4(a, tid, G); transpose_by_idle(a, lds, TI_IN + TI_OUT, TI_IN + TI_OUT + TI_FI, 0, G, wave, lane); } SEAM(4); STAMP(5);
    if (IN(5)) { phase5(a, lds, tid, lane, wave, G); } SEAM(5); STAMP(6);
    if (IN(6)) { __syncthreads(); pg8::Gemm g{(const pg8::bf16_t*)(ws + WS_A), (const pg8::bf16_t*)(ws + WS_WOUT), MX, D, D}; pg8::StaticOrder S; S.init(MX, D, G, (int)blockIdx.x);
        pg8::EpiBf16 E{(pg8::bf16_t*)(ws + WS_MIX), D}; pg8::gemm_phase<pg8::EpiBf16, pg8::StaticOrder, true, true>(lds, g, S, E); } SEAM(6); STAMP(7);
    if (IN(7)) { phase7(a, lane, wave, G); } SEAM(7); STAMP(8);
    if (IN(8)) { __syncthreads(); pg8::Gemm g{(const pg8::bf16_t*)(ws + WS_A), (const pg8::bf16_t*)(ws + WS_WFI), MX, 2 * FF, D}; pg8::StaticOrder S; S.init(MX, 2 * FF, G, (int)blockIdx.x);
        pg8::EpiSwiglu E{(pg8::bf16_t*)(ws + WS_H), FF}; pg8::gemm_phase<pg8::EpiSwiglu, pg8::StaticOrder, true, true>(lds, g, S, E);
        __syncthreads();
        { const int first2 = (72 * 10) % G; const int n2 = (first2 <= 0 || first2 >= G) ? 64 : ((G - first2) < 64 ? (G - first2) : 64);
          const int R = 64 - n2, first8 = (64 * 22) % G;
          int tfirst = first8;
          if (R > 0) {
              if (first8 <= 0 || first8 >= G) { for (int it = 32 + n2 + (int)blockIdx.x; it < 96; it += G) mod_item(a, lds, it, tid, lane, wave); }
              else { const int n8 = G - first8, j = (int)blockIdx.x - first8; if (j >= 0) for (int it = 32 + n2 + j; it < 96; it += n8) mod_item(a, lds, it, tid, lane, wave);
                  const int ng = R < n8 ? R : n8; if (first8 + ng < G) tfirst = first8 + ng; } }
          __syncthreads();
          transpose_by_idle(a, lds, TI_IN + TI_OUT + TI_FI, TI_IN + TI_OUT + TI_FI + TI_FO, tfirst, G, wave, lane); } } SEAM(8); STAMP(9);
    if (IN(9)) { __syncthreads(); pg8::Gemm g{(const pg8::bf16_t*)(ws + WS_H), (const pg8::bf16_t*)(ws + WS_WFO), MX, D, FF}; pg8::StaticOrder S; S.init(MX, D, G, (int)blockIdx.x);
        pg8::EpiBf16 E{(pg8::bf16_t*)(ws + WS_FX), D}; pg8::gemm_phase<pg8::EpiBf16, pg8::StaticOrder, true, true>(lds, g, S, E); } SEAM(9); STAMP(10);
    if (IN(10)) { phase10(a, lane, wave, G); }
    STAMP(11);
#ifdef TSA
    __syncthreads(); if (blockIdx.x == 0 && tid == 0) { asm volatile("s_waitcnt vmcnt(0)" ::: "memory");
#ifdef TSTHR
        if ((float)(tsb - tsa) * 0.01f > TSTHR) a.out[0] = 100.0f;
#else
        a.out[0] = (float)(tsb - tsa) * 0.01f;
#endif
    }
#endif
#undef IN
#undef SEAM
}

#ifndef N_LAUNCH_MODE
#define N_LAUNCH_MODE 1
#endif
extern "C" void kernel_launch(void* const* d_in, const int* in_sizes, int n_in, void* d_out, int out_size, void* d_ws, size_t ws_size, hipStream_t stream) {
    static int grid = 0;
    if (grid == 0) {
        int dev = 0, cus = 0, per_cu = 0;
        hipGetDevice(&dev); hipDeviceGetAttribute(&cus, hipDeviceAttributeMultiprocessorCount, dev);
        if (hipFuncSetAttribute((const void*)fwd_kernel, hipFuncAttributeMaxDynamicSharedMemorySize, LDS_BYTES) != hipSuccess) { fprintf(stderr, "kernel_launch: hipFuncSetAttribute failed\n"); grid = -1; return; }
        if (hipOccupancyMaxActiveBlocksPerMultiprocessor(&per_cu, (const void*)fwd_kernel, NTHR, LDS_BYTES) != hipSuccess || per_cu < 1) { fprintf(stderr, "kernel_launch: occupancy query says %d\n", per_cu); per_cu = 1; }
        (void)hipGetLastError();
        grid = cus * 1;
        if (grid <= 0) grid = 256;
    }
    if (grid < 0) return;
    Args a{};
    const float** ap = (const float**)&a;
    for (int i = 0; i < 18; ++i) ap[i] = (const float*)d_in[i];
    a.out = (float*)d_out; a.ws = (unsigned char*)d_ws;
    if (hipMemsetAsync(d_ws, 0, 16384, stream) != hipSuccess) { fprintf(stderr, "kernel_launch: memset of barrier words failed\n"); return; }
#if N_LAUNCH_MODE == 1
    a.ph_lo = 0; a.ph_hi = 11;
    { void* args[] = {&a}; hipError_t e = hipLaunchCooperativeKernel((const void*)fwd_kernel, dim3(grid), dim3(NTHR), args, LDS_BYTES, stream);
      if (e != hipSuccess) fprintf(stderr, "cooperative launch failed: %s (grid %d)\n", hipGetErrorString(e), grid); }
#else
    for (int p = 0; p < 11; ++p) { a.ph_lo = p; a.ph_hi = p + 1; void* args[] = {&a};
        hipError_t e = hipLaunchCooperativeKernel((const void*)fwd_kernel, dim3(grid), dim3(NTHR), args, LDS_BYTES, stream);
        if (e != hipSuccess) { fprintf(stderr, "launch %d failed: %s (grid %d)\n", p, hipGetErrorString(e), grid); break; } }
#endif
}
```

```cpp
#include <hip/hip_runtime.h>
#include <hip/hip_cooperative_groups.h>
#include <cstdio>
#include <cstdint>
namespace cg = cooperative_groups;
namespace pg8 {
#define PG8_LAS __attribute__((address_space(3)))
typedef unsigned short bf16_t;
typedef short bf16x8 __attribute__((ext_vector_type(8)));
typedef float f32x4 __attribute__((ext_vector_type(4)));
typedef unsigned u32x4 __attribute__((ext_vector_type(4)));
constexpr int BM = 256, BK = 64, HALF = 128, HTB = HALF * BK * 2  , STAGE_BYTES = 8 * HTB, NXCD = 8, WGM = 8;

__host__ __device__ __forceinline__ int lds_byte(int r, int c) { const int st = (r >> 4) * 2 + (c >> 5), rr = r & 15, cc = c & 31, ob = rr * 64 + cc * 2; return st * 1024 + (ob ^ (((ob >> 9) & 1) << 5)); }
__host__ __device__ __forceinline__ void stage_rc(int b, int& R, int& C) { const int st = b / 1024, sb = b % 1024, swz = sb ^ (((sb >> 9) & 1) << 5); R = (st >> 1) * 16 + swz / 64; C = (st & 1) * 32 + (swz % 64) / 2; }
__host__ __device__ __forceinline__ int perm32(int rho) { const int n = rho >> 4, i = rho & 15; return 8 * (i >> 2) + 4 * n + (i & 3); }

struct Unit { int pm, pn; };
struct Gemm { const bf16_t* A; const bf16_t* Bt; int M, N, K; };

struct StaticOrder {
    int nM, nN, nwg, G, c;
    __host__ __device__ void init(int M, int N, int G_, int c_) { nM = M / BM; nN = N / BM; nwg = nM * nN; G = G_; c = c_; }
    __host__ __device__ bool next(int i, Unit& u) const {
        const long L = (long)i * G + c; if (L >= nwg) return false;
        int wgid = (int)L; { const int q = nwg / NXCD, r = nwg % NXCD, xcd = wgid % NXCD, off = wgid / NXCD; wgid = (xcd < r ? xcd * (q + 1) : r * (q + 1) + (xcd - r) * q) + off; }
        const int nig = WGM * nN, gid = wgid / nig, fm = gid * WGM, gsz = (nM - fm) < WGM ? (nM - fm) : WGM;
        u.pm = fm + ((wgid % nig) % gsz); u.pn = (wgid % nig) / gsz; return true;
    }
    __device__ __forceinline__ void a_ready(const Unit&) const {}
    __device__ __forceinline__ void done(const Unit&) const {}
};

__device__ __forceinline__ unsigned cvt_pk_bf16(float lo, float hi) { unsigned r; asm volatile("v_cvt_pk_bf16_f32 %0, %1, %2" : "=v"(r) : "v"(lo), "v"(hi)); return r; }
struct EpiBf16 {
    static constexpr bool PERM = true, AFTER_DRAIN = false;
    bf16_t* O; int ldc;
    __device__ __forceinline__ void operator()(const f32x4 (&acc)[2][2][4][2], const Unit& u, int wr, int wc, int fr, int fq) const {
        const int row0 = u.pm * BM + wr * 64 + fr; const int col0 = u.pn * BM + wc * 32 + 8 * fq;
#pragma unroll
        for (int ai = 0; ai < 2; ++ai)
#pragma unroll
            for (int m = 0; m < 4; ++m) { bf16_t* rowp = O + (size_t)(row0 + ai * HALF + m * 16) * ldc + col0;
#pragma unroll
                for (int bj = 0; bj < 2; ++bj) { const f32x4 v0 = acc[ai][bj][m][0], v1 = acc[ai][bj][m][1];
                    u32x4 w; w.x = cvt_pk_bf16(v0[0], v0[1]); w.y = cvt_pk_bf16(v0[2], v0[3]); w.z = cvt_pk_bf16(v1[0], v1[1]); w.w = cvt_pk_bf16(v1[2], v1[3]);
                    *(u32x4*)(rowp + bj * HALF) = w; } }
    }
};
__device__ __forceinline__ float silu_f(float g) { return g * __builtin_amdgcn_rcpf(1.0f + __builtin_amdgcn_exp2f(-1.44269504089f * g)); }
struct EpiSwiglu {
    static constexpr bool PERM = true, AFTER_DRAIN = false;
    bf16_t* O; int ldc;
    __device__ __forceinline__ void operator()(const f32x4 (&acc)[2][2][4][2], const Unit& u, int wr, int wc, int fr, int fq) const {
        const int row0 = u.pm * BM + wr * 64 + fr; const int col0 = u.pn * HALF + wc * 32 + 8 * fq;
#pragma unroll
        for (int ai = 0; ai < 2; ++ai)
#pragma unroll
            for (int m = 0; m < 4; ++m) { bf16_t* rowp = O + (size_t)(row0 + ai * HALF + m * 16) * ldc + col0;
                const f32x4 g0 = acc[ai][0][m][0], g1 = acc[ai][0][m][1], u0 = acc[ai][1][m][0], u1 = acc[ai][1][m][1];
                u32x4 w; w.x = cvt_pk_bf16(silu_f(g0[0]) * u0[0], silu_f(g0[1]) * u0[1]); w.y = cvt_pk_bf16(silu_f(g0[2]) * u0[2], silu_f(g0[3]) * u0[3]);
                w.z = cvt_pk_bf16(silu_f(g1[0]) * u1[0], silu_f(g1[1]) * u1[1]); w.w = cvt_pk_bf16(silu_f(g1[2]) * u1[2], silu_f(g1[3]) * u1[3]);
                *(u32x4*)rowp = w; }
    }
};
struct EpiInProj {
    static constexpr bool PERM = true, AFTER_DRAIN = false;
    bf16_t* O; int ldc; float* gates;
    __device__ __forceinline__ void operator()(const f32x4 (&acc)[2][2][4][2], const Unit& u, int wr, int wc, int fr, int fq) const {
        const int row0 = u.pm * BM + wr * 64 + fr;
        if (u.pn == 9) {
            if (wc == 0 && fq < 2) {
#pragma unroll
                for (int ai = 0; ai < 2; ++ai)
#pragma unroll
                    for (int m = 0; m < 4; ++m) { float* gp = gates + (size_t)(row0 + ai * HALF + m * 16) * 16 + 8 * fq; *(f32x4*)gp = acc[ai][0][m][0]; *(f32x4*)(gp + 4) = acc[ai][0][m][1]; }
            }
            return;
        }
        const int col0 = u.pn * BM + wc * 32 + 8 * fq;
#pragma unroll
        for (int ai = 0; ai < 2; ++ai)
#pragma unroll
            for (int m = 0; m < 4; ++m) { bf16_t* rowp = O + (size_t)(row0 + ai * HALF + m * 16) * ldc + col0;
#pragma unroll
                for (int bj = 0; bj < 2; ++bj) { const f32x4 v0 = acc[ai][bj][m][0], v1 = acc[ai][bj][m][1];
                    u32x4 w; w.x = cvt_pk_bf16(v0[0], v0[1]); w.y = cvt_pk_bf16(v0[2], v0[3]); w.z = cvt_pk_bf16(v1[0], v1[1]); w.w = cvt_pk_bf16(v1[2], v1[3]);
                    *(u32x4*)(rowp + bj * HALF) = w; } }
    }
};
template <class Epi, class Sched, bool ALIGN_EPI = false, bool SP2 = false>
__device__ __forceinline__ void gemm_phase(PG8_LAS unsigned char* lds, const Gemm g, const Sched& S, const Epi& E) {
    const int tid = threadIdx.x, wid = __builtin_amdgcn_readfirstlane(tid >> 6), lane = tid & 63, wr = wid >> 2, wc = wid & 3, fr = lane & 15, fq = lane >> 4;
    const int K = g.K, nt = K / BK;
    unsigned voffA[2], voffB[2];
#pragma unroll
    for (int i = 0; i < 2; ++i) { int R, C; stage_rc(tid * 16 + i * 8192, R, C); const int Rb = Epi::PERM ? ((R & ~31) + perm32(R & 31)) : R;
        voffA[i] = (unsigned)(R * K + C) * 2u; voffB[i] = (unsigned)(Rb * K + C) * 2u; }
    const size_t kstep = (size_t)(BK * 2);
    const size_t hstep = (size_t)HALF * K * 2;
    const size_t tstep = 2 * hstep;
    const unsigned ldsw = (unsigned)wid * 1024u;
    const int aoff = lds_byte(wr * 64 + fr, fq * 8), boff = lds_byte(wc * 32 + fr, fq * 8);
#define PG8_SA(b, h) (((b) * 2 + (h)) * HTB)
#define PG8_SB(b, h) ((4 + (b) * 2 + (h)) * HTB)
#define PG8_STAGE(bufoff, gbase, voff) do { _Pragma("unroll") for (int _i = 0; _i < 2; ++_i) \
        __builtin_amdgcn_global_load_lds((const unsigned*)((const char*)(gbase) + (voff)[_i]), (PG8_LAS unsigned*)(lds + (bufoff) + ldsw + _i * 8192), 16, 0, 0); } while (0)
#define PG8_LDA(dst, b, h) do { _Pragma("unroll") for (int m = 0; m < 4; ++m) _Pragma("unroll") for (int k = 0; k < 2; ++k) dst[m][k] = *(const PG8_LAS bf16x8*)(lds + PG8_SA(b, h) + aoff + m * 2048 + k * 1024); } while (0)
#define PG8_LDB(dst, b, h) do { _Pragma("unroll") for (int n = 0; n < 2; ++n) _Pragma("unroll") for (int k = 0; k < 2; ++k) dst[n][k] = *(const PG8_LAS bf16x8*)(lds + PG8_SB(b, h) + boff + n * 2048 + k * 1024); } while (0)
#define PG8_MMA(ai, bj, At, Bt) do { __builtin_amdgcn_s_setprio(1); _Pragma("unroll") for (int m = 0; m < 4; ++m) _Pragma("unroll") for (int n = 0; n < 2; ++n) _Pragma("unroll") for (int k = 0; k < 2; ++k) \
        acc[ai][bj][m][n] = __builtin_amdgcn_mfma_f32_16x16x32_bf16(Bt[n][k], At[m][k], acc[ai][bj][m][n], 0, 0, 0); __builtin_amdgcn_s_setprio(0); } while (0)
#define PG8_WAIT_V(n) asm volatile("s_waitcnt vmcnt(" #n ")" ::: "memory")
#define PG8_WAIT_L(n) asm volatile("s_waitcnt lgkmcnt(" #n ")" ::: "memory")
#define PG8_BAR __builtin_amdgcn_s_barrier()
#define PG8_SCHED __builtin_amdgcn_sched_barrier(0)
    Unit cur, nxt; int ui = 0;
    if (!S.next(0, cur)) return;
    f32x4 acc[2][2][4][2];
#pragma unroll
    for (int a = 0; a < 2; ++a)
#pragma unroll
        for (int b = 0; b < 2; ++b)
#pragma unroll
            for (int m = 0; m < 4; ++m)
#pragma unroll
                for (int n = 0; n < 2; ++n) acc[a][b][m][n] = (f32x4){0.f, 0.f, 0.f, 0.f};
    bf16x8 At[4][2], B0[2][2], B1[2][2];
    const char* cA = (const char*)g.A + (size_t)cur.pm * tstep; const char* cB = (const char*)g.Bt + (size_t)cur.pn * tstep;
    S.a_ready(cur);
    if constexpr (SP2) {
        PG8_STAGE(PG8_SB(0, 0), cB, voffB); PG8_STAGE(PG8_SB(0, 1), cB + hstep, voffB); PG8_STAGE(PG8_SA(0, 0), cA, voffA); PG8_STAGE(PG8_SA(0, 1), cA + hstep, voffA);
        if (wr == 1) PG8_BAR;
        PG8_WAIT_V(2); PG8_BAR;
        PG8_STAGE(PG8_SB(1, 0), cB + kstep, voffB); PG8_STAGE(PG8_SA(1, 0), cA + kstep, voffA); PG8_STAGE(PG8_SB(1, 1), cB + hstep + kstep, voffB);
        PG8_WAIT_V(6); PG8_BAR;
    } else {
        PG8_STAGE(PG8_SB(0, 0), cB, voffB); PG8_STAGE(PG8_SA(0, 0), cA, voffA); PG8_STAGE(PG8_SB(0, 1), cB + hstep, voffB); PG8_STAGE(PG8_SA(0, 1), cA + hstep, voffA);
        if (wr == 1) PG8_BAR;
        PG8_WAIT_V(4); PG8_BAR;
        PG8_STAGE(PG8_SB(1, 0), cB + kstep, voffB); PG8_STAGE(PG8_SA(1, 0), cA + kstep, voffA); PG8_STAGE(PG8_SB(1, 1), cB + hstep + kstep, voffB);
        PG8_WAIT_V(6); PG8_BAR;
    }
    for (;;) {
        const bool has_next = S.next(ui + 1, nxt);
        const char* nA = has_next ? (const char*)g.A + (size_t)nxt.pm * tstep : cA; const char* nB = has_next ? (const char*)g.Bt + (size_t)nxt.pn * tstep : cB;
        for (int t = 0; t < nt; t += 2) {
            const bool last = (t == nt - 2);
            const char* a1 = cA + (size_t)(t + 1) * kstep;
            const char* a2 = last ? nA : cA + (size_t)(t + 2) * kstep; const char* b2 = last ? nB : cB + (size_t)(t + 2) * kstep;
            const char* a3 = a2 + kstep; const char* b3 = b2 + kstep;
            if (last && has_next) S.a_ready(nxt);
            if constexpr (SP2) {
            PG8_LDB(B0, 0, 0); PG8_LDB(B1, 0, 1); PG8_SCHED; PG8_LDA(At, 0, 0); PG8_STAGE(PG8_SA(1, 1), a1 + hstep, voffA);
            PG8_WAIT_V(8); PG8_WAIT_L(0); PG8_BAR; PG8_MMA(0, 0, At, B0); PG8_MMA(0, 1, At, B1); PG8_BAR; PG8_SCHED;
            PG8_LDA(At, 0, 1); PG8_STAGE(PG8_SB(0, 0), b2, voffB); PG8_STAGE(PG8_SB(0, 1), b2 + hstep, voffB); PG8_STAGE(PG8_SA(0, 0), a2, voffA);
            PG8_WAIT_V(8); PG8_WAIT_L(0); PG8_BAR; PG8_MMA(1, 0, At, B0); PG8_MMA(1, 1, At, B1); PG8_BAR; PG8_SCHED;
            PG8_LDB(B0, 1, 0); PG8_LDB(B1, 1, 1); PG8_SCHED; PG8_LDA(At, 1, 0); PG8_STAGE(PG8_SA(0, 1), a2 + hstep, voffA);
            PG8_WAIT_V(8); PG8_WAIT_L(0); PG8_BAR; PG8_MMA(0, 0, At, B0); PG8_MMA(0, 1, At, B1); PG8_BAR; PG8_SCHED;
            PG8_LDA(At, 1, 1); PG8_STAGE(PG8_SB(1, 0), b3, voffB); PG8_STAGE(PG8_SB(1, 1), b3 + hstep, voffB); PG8_STAGE(PG8_SA(1, 0), a3, voffA);
            PG8_WAIT_V(8); PG8_WAIT_L(0); PG8_BAR; PG8_MMA(1, 0, At, B0); PG8_MMA(1, 1, At, B1); PG8_BAR; PG8_SCHED;
            } else {
            PG8_LDB(B0, 0, 0); PG8_SCHED; PG8_LDA(At, 0, 0); PG8_STAGE(PG8_SA(1, 1), a1 + hstep, voffA);
            PG8_WAIT_L(8); PG8_BAR; PG8_WAIT_L(0); PG8_MMA(0, 0, At, B0); PG8_BAR; PG8_SCHED;
            PG8_LDB(B1, 0, 1); PG8_STAGE(PG8_SB(0, 0), b2, voffB);
            PG8_BAR; PG8_WAIT_L(0); PG8_MMA(0, 1, At, B1); PG8_BAR;
            PG8_LDA(At, 0, 1); PG8_STAGE(PG8_SA(0, 0), a2, voffA);
            PG8_BAR; PG8_WAIT_L(0); PG8_MMA(1, 0, At, B0); PG8_BAR; PG8_SCHED;
            PG8_STAGE(PG8_SB(0, 1), b2 + hstep, voffB);
            PG8_WAIT_V(6); PG8_BAR; PG8_MMA(1, 1, At, B1); PG8_BAR;
            PG8_LDB(B0, 1, 0); PG8_SCHED; PG8_LDA(At, 1, 0); PG8_STAGE(PG8_SA(0, 1), a2 + hstep, voffA);
            PG8_WAIT_L(8); PG8_BAR; PG8_WAIT_L(0); PG8_MMA(0, 0, At, B0); PG8_BAR; PG8_SCHED;
            PG8_LDB(B1, 1, 1); PG8_STAGE(PG8_SB(1, 0), b3, voffB);
            PG8_BAR; PG8_WAIT_L(0); PG8_MMA(0, 1, At, B1); PG8_BAR;
            PG8_LDA(At, 1, 1); PG8_STAGE(PG8_SA(1, 0), a3, voffA);
            PG8_BAR; PG8_WAIT_L(0); PG8_MMA(1, 0, At, B0); PG8_BAR; PG8_SCHED;
            PG8_STAGE(PG8_SB(1, 1), b3 + hstep, voffB);
            PG8_WAIT_V(6); PG8_BAR; PG8_MMA(1, 1, At, B1); PG8_BAR;
            }
        }
        if constexpr (ALIGN_EPI) { if (wr == 0) PG8_BAR; }
        if constexpr (!Epi::AFTER_DRAIN) { E(acc, cur, wr, wc, fr, fq); S.done(cur); }
        if (!has_next) break;
#pragma unroll
        for (int a = 0; a < 2; ++a)
#pragma unroll
            for (int b = 0; b < 2; ++b)
#pragma unroll
                for (int m = 0; m < 4; ++m)
#pragma unroll
                    for (int n = 0; n < 2; ++n) acc[a][b][m][n] = (f32x4){0.f, 0.f, 0.f, 0.f};
        cur = nxt; cA = nA; cB = nB; ++ui;
        if constexpr (ALIGN_EPI) { if (wr == 1) PG8_BAR; }
    }
    PG8_WAIT_V(0);
    if constexpr (!ALIGN_EPI) { if (wr == 0) PG8_BAR; }
    PG8_BAR;
    if constexpr (Epi::AFTER_DRAIN) { E.fused(acc, cur, wr, wc, fr, fq, lds, wid, lane); S.done(cur); }
#undef PG8_SA
#undef PG8_SB
#undef PG8_STAGE
#undef PG8_LDA
#undef PG8_LDB
#undef PG8_MMA
#undef PG8_WAIT_V
#undef PG8_WAIT_L
#undef PG8_BAR
#undef PG8_SCHED
}
}

#define LAS __attribute__((address_space(3)))
typedef unsigned short bf16;
typedef float f32x4 __attribute__((ext_vector_type(4)));
typedef float f32x2 __attribute__((ext_vector_type(2)));
typedef short bf16x8 __attribute__((ext_vector_type(8)));
typedef unsigned u32x4 __attribute__((ext_vector_type(4)));
typedef unsigned u32x2 __attribute__((ext_vector_type(2)));
constexpr int NWAVES = 8, NTHR = 512;
constexpr int D = 1024, NB = 8, SEQ = 2048, CTXL = 256, MX = NB * SEQ, MC = NB * CTXL, MT = MX + MC;
constexpr int NIN = 2304, INW = 2320, FF = 2816;
constexpr int C_AQ = 0, C_AK = 512, C_AV = 640, C_MQ = 768, C_MK = 1024, C_MV = 1280, C_MO = 1792;
constexpr int NCH = 36;
constexpr int STSZ = 8256;
constexpr float EPSF = 1e-6f;
constexpr size_t MiB = 1u << 20;
constexpr size_t WS_MOD = 1 * MiB;
constexpr size_t WS_ROPE = 1 * MiB + 512 * 1024;
constexpr size_t WS_WIN = 2 * MiB, WS_WOUT = 7 * MiB, WS_WFI = 9 * MiB, WS_WFO = 20 * MiB;
constexpr size_t WS_GATES = 26 * MiB;
constexpr size_t WS_SCAL = 28 * MiB;
constexpr size_t WS_A = 30 * MiB;
constexpr size_t WS_PX = 66 * MiB;
constexpr size_t WS_QKS = 147 * MiB;
constexpr size_t WS_ST = 165 * MiB;
constexpr size_t WS_STN = 202 * MiB;
constexpr size_t WS_CP = 203 * MiB;
constexpr size_t WS_NP = 240 * MiB;
constexpr size_t WS_MIX = 66 * MiB;
constexpr size_t WS_H = 100 * MiB;
constexpr size_t WS_FX = 190 * MiB;
constexpr int LDS_BYTES = 139264;
constexpr int CW_MODCNT = 3712;

struct Args {
    const float *x, *c, *ctx, *c_ctx, *w_ada, *b_ada, *g_pre_mix, *w_in, *w_conv, *b_gates, *sink, *g_ml, *w_out, *g_post_mix, *g_pre_ffn, *w_ffi, *w_ffo, *g_post_ffn;
    float* out; unsigned char* ws; int ph_lo, ph_hi;
};

__device__ __forceinline__ unsigned f2bf(float f) { unsigned u = __builtin_bit_cast(unsigned, f); return (u + 0x7fffu + ((u >> 16) & 1u)) >> 16; }
__device__ __forceinline__ unsigned pk2(float lo, float hi) { return f2bf(lo) | (f2bf(hi) << 16); }
__device__ __forceinline__ float bf2f(unsigned h) { return __builtin_bit_cast(float, h << 16); }
__device__ __forceinline__ float bflo(unsigned w) { return __builtin_bit_cast(float, w << 16); }
__device__ __forceinline__ float bfhi(unsigned w) { return __builtin_bit_cast(float, w & 0xffff0000u); }

template <int CTRL> __device__ __forceinline__ float dpp_f(float v) { return __builtin_bit_cast(float, __builtin_amdgcn_update_dpp(0, __builtin_bit_cast(int, v), CTRL, 0xF, 0xF, true)); }
__device__ __forceinline__ float red16_sum(float v) { v += dpp_f<0xB1>(v); v += dpp_f<0x4E>(v); v += dpp_f<0x141>(v); v += dpp_f<0x140>(v); return v; }
__device__ __forceinline__ float red16_max(float v) { v = fmaxf(v, dpp_f<0xB1>(v)); v = fmaxf(v, dpp_f<0x4E>(v)); v = fmaxf(v, dpp_f<0x141>(v)); v = fmaxf(v, dpp_f<0x140>(v)); return v; }
__device__ __forceinline__ float wave_sum(float v) { v = red16_sum(v); v += __shfl_xor(v, 16); v += __shfl_xor(v, 32); return v; }
__device__ __forceinline__ float wave_max(float v) { v = red16_max(v); v = fmaxf(v, __shfl_xor(v, 16)); v = fmaxf(v, __shfl_xor(v, 32)); return v; }
__device__ __forceinline__ float fexp(float x) { return __builtin_amdgcn_exp2f(x * 1.44269504089f); }
__device__ __forceinline__ float frcp(float x) { return __builtin_amdgcn_rcpf(x); }
__device__ __forceinline__ float scan_sum_up(float v, int lane) {
#pragma unroll
    for (int o = 1; o < 64; o <<= 1) { const float t = __shfl_up(v, o); if (lane >= o) v += t; }
    return v;
}
__device__ __forceinline__ float scan_max_up(float v, int lane) {
#pragma unroll
    for (int o = 1; o < 64; o <<= 1) { const float t = __shfl_up(v, o); if (lane >= o) v = fmaxf(v, t); }
    return v;
}
__device__ __forceinline__ float scan_sum_down(float v, int lane) {
#pragma unroll
    for (int o = 1; o < 64; o <<= 1) { const float t = __shfl_down(v, o); if (lane + o < 64) v += t; }
    return v;
}
__device__ __forceinline__ float scan_max_down(float v, int lane) {
#pragma unroll
    for (int o = 1; o < 64; o <<= 1) { const float t = __shfl_down(v, o); if (lane + o < 64) v = fmaxf(v, t); }
    return v;
}
__device__ __forceinline__ float logsig(float f) { return fminf(f, 0.f) - log1pf(expf(-fabsf(f))); }
__device__ __forceinline__ f32x4 mfma16(bf16x8 a, bf16x8 b, f32x4 c) { return __builtin_amdgcn_mfma_f32_16x16x32_bf16(a, b, c, 0, 0, 0); }
#define LDS_WAIT() asm volatile("s_waitcnt lgkmcnt(0)" ::: "memory")
typedef short v4i16_t __attribute__((ext_vector_type(4)));
__device__ __forceinline__ u32x2 tr4(const LAS bf16* blk, int stride, int lane) { const int li = lane & 15;
    const v4i16_t v = __builtin_amdgcn_ds_read_tr16_b64_v4i16((LAS v4i16_t*)(blk + (li >> 2) * stride + (li & 3) * 4)); return __builtin_bit_cast(u32x2, v); }
__device__ __forceinline__ bf16x8 tr8(const LAS bf16* blk_lo, const LAS bf16* blk_hi, int stride, int lane) { const u32x2 lo = tr4(blk_lo, stride, lane), hi = tr4(blk_hi, stride, lane);
    u32x4 w; w.x = lo.x; w.y = lo.y; w.z = hi.x; w.w = hi.y; return __builtin_bit_cast(bf16x8, w); }
typedef __bf16 bf16x2_t __attribute__((ext_vector_type(2)));
__device__ __forceinline__ unsigned cvtpk(float lo, float hi) { const f32x2 v = {lo, hi}; const bf16x2_t b = __builtin_convertvector(v, bf16x2_t); return __builtin_bit_cast(unsigned, b); }

__device__ __forceinline__ void transpose_item(const float* W, int ldw, int K, bf16* WT, int dst_row0, int k0, int n0, LAS float* scr, int lane, int nvalid = 32) {
    const int cc = (lane & 31) < nvalid ? (lane & 31) : nvalid - 1;
    float tv[32];
#pragma unroll
    for (int i = 0; i < 32; ++i) { const int kk = 2 * i + (lane >> 5); tv[i] = __builtin_nontemporal_load(W + (size_t)(k0 + kk) * ldw + n0 + cc); }
#pragma unroll
    for (int i = 0; i < 32; ++i) { const int kk = 2 * i + (lane >> 5); scr[kk * 33 + (lane & 31)] = tv[i]; }
    LDS_WAIT(); asm volatile("" ::: "memory");
    const int c = lane & 7;
#pragma unroll
    for (int j = 0; j < 4; ++j) { const int n = (lane >> 3) + 8 * j; const LAS float* s = scr + (8 * c) * 33 + n;
        u32x4 o; o.x = pk2(s[0 * 33], s[1 * 33]); o.y = pk2(s[2 * 33], s[3 * 33]); o.z = pk2(s[4 * 33], s[5 * 33]); o.w = pk2(s[6 * 33], s[7 * 33]);
        *(u32x4*)(WT + (size_t)(dst_row0 + n) * K + k0 + 8 * c) = o; }
    LDS_WAIT(); asm volatile("" ::: "memory");
}

__device__ __forceinline__ void mod_item(const Args& a, LAS unsigned char* lds, int it, int tid, int lane, int wave) {
    float* mod = (float*)(a.ws + WS_MOD);
        LAS float* sv = (LAS float*)lds;
        LAS float* red = (LAS float*)(lds + 40960);
        for (int i = tid; i < 9 * 1024; i += NTHR) { const int r = i >> 10, k = i & 1023; const float cv = r < 8 ? a.c[r * 1024 + k] : a.c_ctx[k]; sv[i] = cv / (1.0f + expf(-cv)); }
        __syncthreads();
        const int cq = tid & 15, kg = tid >> 4, j0 = it * 64;
        f32x4 acc[9];
#pragma unroll
        for (int r = 0; r < 9; ++r) acc[r] = (f32x4){0.f, 0.f, 0.f, 0.f};
        for (int k0 = 0; k0 < 32; k0 += 16) { f32x4 wv[16];
#pragma unroll
            for (int kk = 0; kk < 16; ++kk) wv[kk] = __builtin_nontemporal_load((const f32x4*)(a.w_ada + (size_t)(kg * 32 + k0 + kk) * 6144 + j0 + cq * 4));
#pragma unroll
            for (int kk = 0; kk < 16; ++kk) { const int k = kg * 32 + k0 + kk;
#pragma unroll
                for (int r = 0; r < 9; ++r) acc[r] += sv[r * 1024 + k] * wv[kk]; } }
#pragma unroll
        for (int r = 0; r < 9; ++r)
#pragma unroll
            for (int e = 0; e < 4; ++e) { float v = acc[r][e]; v += __shfl_xor(v, 16); v += __shfl_xor(v, 32); acc[r][e] = v; }
        if (lane < 16) {
#pragma unroll
            for (int r = 0; r < 9; ++r)
#pragma unroll
                for (int e = 0; e < 4; ++e) red[(wave * 9 + r) * 64 + cq * 4 + e] = acc[r][e];
        }
        __syncthreads();
        for (int i = tid; i < 9 * 64; i += NTHR) { const int r = i >> 6, col = i & 63; float s = a.b_ada[j0 + col];
#pragma unroll
            for (int w = 0; w < 8; ++w) s += red[(w * 9 + r) * 64 + col];
            mod[r * 6144 + j0 + col] = s; }
        __syncthreads();
    }

constexpr int TI_IN = 16 * 73, TI_OUT = 16 * 32, TI_FI = 16 * 176, TI_FO = 44 * 32;
__device__ __forceinline__ void transpose_items(const Args& a, LAS unsigned char* lds, int lo, int hi, int worker, int nworkers, int wave, int lane) {
    unsigned char* ws = a.ws; LAS float* scr = (LAS float*)(lds + wave * 8448);
    for (int it = lo + worker; it < hi; it += nworkers) {
        int r = it;
        if (r < TI_IN) { const int kb = r / 73, nb = r % 73; transpose_item(a.w_in, INW, D, (bf16*)(ws + WS_WIN), 32 * nb, 64 * kb, 32 * nb, scr, lane, nb == 72 ? 16 : 32); continue; } r -= TI_IN;
        if (r < TI_OUT) { const int kb = r / 32, nb = r % 32; transpose_item(a.w_out, D, D, (bf16*)(ws + WS_WOUT), 32 * nb, 64 * kb, 32 * nb, scr, lane); continue; } r -= TI_OUT;
        if (r < TI_FI) { const int kb = r / 176, nb = r % 176; const int n0 = 32 * nb, bj = n0 >= FF ? 1 : 0, jj = n0 - bj * FF; const int dst = 256 * (jj >> 7) + 128 * bj + (jj & 127);
            transpose_item(a.w_ffi, 2 * FF, D, (bf16*)(ws + WS_WFI), dst, 64 * kb, n0, scr, lane); continue; } r -= TI_FI;
        { const int kb = r / 32, nb = r % 32; transpose_item(a.w_ffo, D, FF, (bf16*)(ws + WS_WFO), 32 * nb, 64 * kb, 32 * nb, scr, lane); }
    }
}
__device__ __forceinline__ void transpose_by_idle(const Args& a, LAS unsigned char* lds, int lo, int hi, int first, int G, int wave, int lane) {
    if (first <= 0 || first >= G) transpose_items(a, lds, lo, hi, blockIdx.x * NWAVES + wave, G * NWAVES, wave, lane);
    else if ((int)blockIdx.x >= first) transpose_items(a, lds, lo, hi, ((int)blockIdx.x - first) * NWAVES + wave, (G - first) * NWAVES, wave, lane);
}

__device__ __forceinline__ void phase0(const Args& a, LAS unsigned char* lds, int tid, int lane, int wave, int G) {
    unsigned char* ws = a.ws;
    float* mod = (float*)(ws + WS_MOD);
    { float* rope = (float*)(ws + WS_ROPE);
      for (int i = blockIdx.x * NTHR + tid; i < 96 * 16; i += G * NTHR) { const int pos = i >> 4, f = i & 15; const float inv = powf(10000.0f, -(float)f / 16.0f);
          const float ang = (float)(pos < 32 ? pos : pos - 32) * inv; rope[2 * i] = cosf(ang); rope[2 * i + 1] = sinf(ang); } }
    for (int it = G - 1 - (int)blockIdx.x; it < 32; it += G) { mod_item(a, lds, it, tid, lane, wave);
        asm volatile("s_waitcnt vmcnt(0)" ::: "memory"); __syncthreads();
        if (tid == 0) { __builtin_amdgcn_fence(__ATOMIC_RELEASE, "agent"); asm volatile("s_waitcnt vmcnt(0)" ::: "memory");
            (void)__hip_atomic_fetch_add((unsigned*)a.ws + CW_MODCNT, 1u, __ATOMIC_RELAXED, __HIP_MEMORY_SCOPE_AGENT); } }
    transpose_items(a, lds, 0, TI_IN, blockIdx.x * NWAVES + wave, G * NWAVES, wave, lane);
}

__device__ __forceinline__ void phase1(const Args& a, LAS unsigned char* lds, int tid, int lane, int wave, int G) {
    unsigned char* ws = a.ws; const float* mod = (const float*)(ws + WS_MOD);
    bf16* A = (bf16*)(ws + WS_A);
    const int gw = blockIdx.x * NWAVES + wave, NGW = G * NWAVES;
    f32x4 nxa[4], nxb[4];
#define P1_LOAD(dst_, row_) do { const int r_ = (row_); if (r_ < MT) { const float* xr_ = r_ < MX ? a.x + (size_t)r_ * D : a.ctx + (size_t)(r_ - MX) * D; \
        _Pragma("unroll") for (int j_ = 0; j_ < 4; ++j_) dst_[j_] = __builtin_nontemporal_load((const f32x4*)xr_ + lane + 64 * j_); } } while (0)
    P1_LOAD(nxa, gw); P1_LOAD(nxb, gw + NGW);
    if (tid == 0) { unsigned sp = 0u; while (__hip_atomic_load((unsigned*)a.ws + CW_MODCNT, __ATOMIC_RELAXED, __HIP_MEMORY_SCOPE_AGENT) < 32u && ++sp < (1u << 22)) __builtin_amdgcn_s_sleep(1);
        __builtin_amdgcn_fence(__ATOMIC_ACQUIRE, "agent"); asm volatile("s_waitcnt vmcnt(0)" ::: "memory"); }
    __syncthreads();
    for (int row = gw; row < MT; row += NGW) {
        const float* mrow = mod + (row < MX ? (row >> 11) : 8) * 6144;
        f32x4 v[4]; float ss = 0.f;
#pragma unroll
        for (int j = 0; j < 4; ++j) { v[j] = nxa[j]; nxa[j] = nxb[j]; ss += (v[j].x * v[j].x + v[j].y * v[j].y) + (v[j].z * v[j].z + v[j].w * v[j].w); }
        P1_LOAD(nxb, row + 2 * NGW);
        const float rstd = rsqrtf(wave_sum(ss) * (1.0f / D) + EPSF);
#pragma unroll
        for (int j = 0; j < 4; ++j) { const int k = 4 * lane + 256 * j;
            const f32x4 g = *(const f32x4*)(a.g_pre_mix + k), sh = *(const f32x4*)(mrow + k), sc = *(const f32x4*)(mrow + 1024 + k);
            v[j] = (v[j] * rstd * g) * (1.0f + sc) + sh;
            u32x2 o; o.x = cvtpk(v[j].x, v[j].y); o.y = cvtpk(v[j].z, v[j].w);
            *(u32x2*)(A + (size_t)row * D + k) = o; }
    }
#undef P1_LOAD
}

constexpr int ATT_KV_OFF = 36864, ATT_ROPE_OFF = 73728;
__device__ __forceinline__ void attn_stage_rope(const Args& a, LAS unsigned char* lds, int tid) {
    const float* rope = (const float*)(a.ws + WS_ROPE); LAS float* rl = (LAS float*)(lds + ATT_ROPE_OFF);
    for (int i = tid; i < 96 * 32; i += NTHR) rl[i] = rope[i];
}
__device__ __forceinline__ void attn_unit(const Args& a, LAS unsigned char* lds, int unit, int tid, int lane, int wave) {
    unsigned char* ws = a.ws; const bf16* px = (const bf16*)(ws + WS_PX); bf16* mixcat = (bf16*)(ws + WS_A);
    const int hp = unit & 1, qb = (unit >> 1) & 15, hk = (unit >> 5) & 1, b = unit >> 6;
    LAS bf16* Qs = (LAS bf16*)lds;
    const LAS float* rl = (const LAS float*)(lds + ATT_ROPE_OFF);
    const int fr = lane & 15, fq = lane >> 4;
    constexpr float QSCALE = 0.125f * 1.44269504089f;
    const int tfirst = (qb == 0) ? 2 : 0;
    u32x4 kw1, kw2, vw;
#define ATT_NEXT(t_) (((t_) + 1 < 6 && (qb * 2 - 2 + (t_) + 1) >= 32) ? 6 : (t_) + 1)
#define ATT_PREFETCH(tile_) do { const int t_ = (tile_); const bool lat_ = t_ < 6; \
        const size_t kr_ = lat_ ? (size_t)(b * SEQ + (qb * 2 - 2 + t_) * 64) : (size_t)(MX + b * CTXL + (t_ - 6) * 64); \
        if (lat_) { if (tid < 256) { const int key = tid >> 2, part = tid & 3; const bf16* src = px + (kr_ + key) * NIN + C_AK + hk * 64 + (part >> 1) * 32 + (part & 1) * 8; kw1 = *(const u32x4*)src; kw2 = *(const u32x4*)(src + 16); } } \
        else { kw1 = *(const u32x4*)(px + (kr_ + (tid >> 3)) * NIN + C_AK + hk * 64 + (tid & 7) * 8); } \
        vw = *(const u32x4*)(px + (kr_ + (tid >> 3)) * NIN + C_AV + hk * 64 + (tid & 7) * 8); } while (0)
#define ATT_WRITE(buf_, tile_) do { const int t_ = (tile_); LAS bf16* Kb_ = (LAS bf16*)(lds + ATT_KV_OFF + (buf_) * 18432); LAS bf16* Vb_ = Kb_ + 4608; \
        if (t_ < 6) { if (tid < 256) { const int key = tid >> 2, part = tid & 3, half = part >> 1, sub = (part & 1) * 8; const int pos = (qb * 2 - 2 + t_) * 64 + key; \
                const LAS float* tb = rl + ((half == 0 ? (pos >> 6) : 32 + (pos & 63)) * 16 + sub) * 2; u32x4 o1, o2; \
                _Pragma("unroll") for (int i = 0; i < 4; ++i) { const f32x4 cs = *(const LAS f32x4*)(tb + 4 * i); \
                    const float u1a = bflo(kw1[i]), u1b = bfhi(kw1[i]), u2a = bflo(kw2[i]), u2b = bfhi(kw2[i]); \
                    o1[i] = cvtpk(u1a * cs.x - u2a * cs.y, u1b * cs.z - u2b * cs.w); o2[i] = cvtpk(u2a * cs.x + u1a * cs.y, u2b * cs.z + u1b * cs.w); } \
                *(LAS u32x4*)(Kb_ + key * 72 + half * 32 + sub) = o1; *(LAS u32x4*)(Kb_ + key * 72 + half * 32 + 16 + sub) = o2; } } \
        else { *(LAS u32x4*)(Kb_ + (tid >> 3) * 72 + (tid & 7) * 8) = kw1; } \
        *(LAS u32x4*)(Vb_ + (tid >> 3) * 72 + (tid & 7) * 8) = vw; } while (0)
    ATT_PREFETCH(tfirst);
    __syncthreads();
#pragma unroll
    for (int tt = 0; tt < 2; ++tt) { const int task = tid + tt * NTHR; const int r = task >> 2, part = task & 3, half = part >> 1, sub = (part & 1) * 8;
        const int pos = qb * 128 + (r & 127), head = hk * 4 + hp * 2 + (r >> 7);
        const bf16* src = px + (size_t)(b * SEQ + pos) * NIN + C_AQ + head * 64 + half * 32 + sub;
        const u32x4 w1 = *(const u32x4*)src, w2 = *(const u32x4*)(src + 16);
        const LAS float* tb = rl + ((half == 0 ? (pos >> 6) : 32 + (pos & 63)) * 16 + sub) * 2;
        u32x4 o1, o2;
#pragma unroll
        for (int i = 0; i < 4; ++i) { const f32x4 cs = *(const LAS f32x4*)(tb + 4 * i) * QSCALE;
            const float u1a = bflo(w1[i]), u1b = bfhi(w1[i]), u2a = bflo(w2[i]), u2b = bfhi(w2[i]);
            o1[i] = cvtpk(u1a * cs.x - u2a * cs.y, u1b * cs.z - u2b * cs.w); o2[i] = cvtpk(u2a * cs.x + u1a * cs.y, u2b * cs.z + u1b * cs.w); }
        *(LAS u32x4*)(Qs + r * 72 + half * 32 + sub) = o1; *(LAS u32x4*)(Qs + r * 72 + half * 32 + 16 + sub) = o2; }
    ATT_WRITE(0, tfirst);
    { const int t1 = ATT_NEXT(tfirst); if (t1 < 10) ATT_PREFETCH(t1); }
    __syncthreads();
    bf16x8 qf[2][2];
#pragma unroll
    for (int rt = 0; rt < 2; ++rt)
#pragma unroll
        for (int kk = 0; kk < 2; ++kk) qf[rt][kk] = *(const LAS bf16x8*)(Qs + (wave * 32 + rt * 16 + fr) * 72 + kk * 32 + fq * 8);
    const int head = hk * 4 + hp * 2 + (wave >> 2);
    const float sinkv = a.sink[head] * 1.44269504089f;
    float mrun[2], lrun[2]; f32x4 OT[2][4];
#pragma unroll
    for (int rt = 0; rt < 2; ++rt) { mrun[rt] = sinkv; lrun[rt] = (fq == 0) ? 1.0f : 0.0f;
#pragma unroll
        for (int dt = 0; dt < 4; ++dt) OT[rt][dt] = (f32x4){0.f, 0.f, 0.f, 0.f}; }
    const int qbase = qb * 128 + (wave & 3) * 32;
    int cur = 0;
    for (int tile = tfirst; tile < 10; ) {
        const bool lat = tile < 6; const int key0 = (qb * 2 - 2 + tile) * 64;
        const int nxt = ATT_NEXT(tile);
        if (nxt < 10) { ATT_WRITE(cur ^ 1, nxt); const int n2 = ATT_NEXT(nxt); if (n2 < 10) ATT_PREFETCH(n2); }
        const LAS bf16* Ks = (const LAS bf16*)(lds + ATT_KV_OFF + cur * 18432); const LAS bf16* Vn = Ks + 4608;
        f32x4 sc[2][4];
#pragma unroll
        for (int kt4 = 0; kt4 < 4; ++kt4) { const bf16x8 kf0 = *(const LAS bf16x8*)(Ks + (kt4 * 16 + fr) * 72 + fq * 8), kf1 = *(const LAS bf16x8*)(Ks + (kt4 * 16 + fr) * 72 + 32 + fq * 8);
#pragma unroll
            for (int rt = 0; rt < 2; ++rt) { f32x4 acc = mfma16(kf0, qf[rt][0], (f32x4){0.f, 0.f, 0.f, 0.f}); sc[rt][kt4] = mfma16(kf1, qf[rt][1], acc); } }
        const bool need_mask = lat && (tile <= 1 || tile >= 4);
        bf16x8 pf[2][2];
#pragma unroll
        for (int rt = 0; rt < 2; ++rt) {
            if (need_mask) { const int qpos = qbase + rt * 16 + fr;
#pragma unroll
                for (int kt4 = 0; kt4 < 4; ++kt4)
#pragma unroll
                    for (int j = 0; j < 4; ++j) { const int dpos = qpos - (key0 + kt4 * 16 + fq * 4 + j); if (dpos > 128 || dpos < -128) sc[rt][kt4][j] = -INFINITY; } }
            float mx = -INFINITY;
#pragma unroll
            for (int kt4 = 0; kt4 < 4; ++kt4) mx = fmaxf(mx, fmaxf(fmaxf(sc[rt][kt4][0], sc[rt][kt4][1]), fmaxf(sc[rt][kt4][2], sc[rt][kt4][3])));
            mx = fmaxf(mx, __shfl_xor(mx, 16)); mx = fmaxf(mx, __shfl_xor(mx, 32));
            const float mnew = fmaxf(mrun[rt], mx), alpha = __builtin_amdgcn_exp2f(mrun[rt] - mnew); mrun[rt] = mnew;
            f32x4 ps4 = (f32x4){0.f, 0.f, 0.f, 0.f};
#pragma unroll
            for (int kt4 = 0; kt4 < 4; ++kt4) { f32x4 t = sc[rt][kt4] - mnew;
                t[0] = __builtin_amdgcn_exp2f(t[0]); t[1] = __builtin_amdgcn_exp2f(t[1]); t[2] = __builtin_amdgcn_exp2f(t[2]); t[3] = __builtin_amdgcn_exp2f(t[3]);
                ps4 += t; sc[rt][kt4] = t; }
            const float ps = (ps4[0] + ps4[1]) + (ps4[2] + ps4[3]);
            lrun[rt] = lrun[rt] * alpha + ps;
#pragma unroll
            for (int dt = 0; dt < 4; ++dt) OT[rt][dt] *= alpha;
#pragma unroll
            for (int kk = 0; kk < 2; ++kk) { u32x4 w; w.x = cvtpk(sc[rt][2 * kk][0], sc[rt][2 * kk][1]); w.y = cvtpk(sc[rt][2 * kk][2], sc[rt][2 * kk][3]);
                w.z = cvtpk(sc[rt][2 * kk + 1][0], sc[rt][2 * kk + 1][1]); w.w = cvtpk(sc[rt][2 * kk + 1][2], sc[rt][2 * kk + 1][3]); pf[rt][kk] = __builtin_bit_cast(bf16x8, w); }
        }
#pragma unroll
        for (int kk = 0; kk < 2; ++kk)
#pragma unroll
            for (int dt = 0; dt < 4; ++dt) { const bf16x8 vf = tr8(Vn + (kk * 32 + fq * 4) * 72 + dt * 16, Vn + (kk * 32 + 16 + fq * 4) * 72 + dt * 16, 72, lane);
#pragma unroll
                for (int rt = 0; rt < 2; ++rt) OT[rt][dt] = mfma16(vf, pf[rt][kk], OT[rt][dt]); }
        __syncthreads();
        cur ^= 1; tile = nxt;
    }
#undef ATT_PREFETCH
#undef ATT_WRITE
#undef ATT_NEXT
#pragma unroll
    for (int rt = 0; rt < 2; ++rt) { float l = lrun[rt]; l += __shfl_xor(l, 16); l += __shfl_xor(l, 32); const float inv = 1.0f / l; const int qpos = qbase + rt * 16 + fr;
        bf16* orow = mixcat + (size_t)(b * SEQ + qpos) * D + head * 64 + fq * 4;
#pragma unroll
        for (int dt = 0; dt < 4; ++dt) { u32x2 o; o.x = cvtpk(OT[rt][dt][0] * inv, OT[rt][dt][1] * inv); o.y = cvtpk(OT[rt][dt][2] * inv, OT[rt][dt][3] * inv); *(u32x2*)(orow + dt * 16) = o; } }
}

__device__ __forceinline__ void phase3_mllocal(const Args& a, LAS unsigned char* lds, int tid, int lane, int wave, int G) {
    unsigned char* ws = a.ws; const bf16* px = (const bf16*)(ws + WS_PX); const float* gates = (const float*)(ws + WS_GATES);
    bf16* qks = (bf16*)(ws + WS_QKS); float* scal = (float*)(ws + WS_SCAL); bf16* stC = (bf16*)(ws + WS_ST); float* stN = (float*)(ws + WS_STN);
    LAS float* gl = (LAS float*)lds;
    LAS bf16* Kn = (LAS bf16*)(lds + 2048);
    LAS bf16* WV = (LAS bf16*)(lds + 2048 + 9216);
    const int fr = lane & 15, fq = lane >> 4;
    constexpr int NU = NB * NCH * 4;
    u32x4 rc[3][2], rv0, rv1; float rw[3][16]; float rg0 = 0.f, rg1 = 0.f, rg2 = 0.f, rg3 = 0.f;
#define ML3_LOAD(unit_) do { const int u_ = (unit_); const int h_ = u_ & 3, bc_ = u_ >> 2, c36_ = bc_ % NCH, b_ = bc_ / NCH; \
        const int T_ = c36_ < 4 ? CTXL : SEQ, t0_ = c36_ < 4 ? c36_ * 64 : (c36_ - 4) * 64; const size_t rb_ = c36_ < 4 ? (size_t)(MX + b_ * CTXL) : (size_t)(b_ * SEQ); \
        const int s_ = tid >> 3, cg8_ = tid & 7, isk_ = cg8_ >> 2, c0_ = (cg8_ & 3) * 16; const int col_ = (isk_ ? C_MK : C_MQ) + h_ * 64 + c0_, wch_ = isk_ * 256 + h_ * 64 + c0_; \
        _Pragma("unroll") for (int dt_ = 0; dt_ < 3; ++dt_) { const int tt_ = t0_ + s_ + dt_ - 1; \
            if (tt_ >= 0 && tt_ < T_) { const bf16* src_ = px + (rb_ + tt_) * NIN + col_; rc[dt_][0] = *(const u32x4*)src_; rc[dt_][1] = *(const u32x4*)(src_ + 8); } \
            else { rc[dt_][0] = (u32x4){0u, 0u, 0u, 0u}; rc[dt_][1] = (u32x4){0u, 0u, 0u, 0u}; } \
            _Pragma("unroll") for (int i_ = 0; i_ < 4; ++i_) { const f32x4 w_ = *(const f32x4*)(a.w_conv + dt_ * 512 + wch_ + 4 * i_); rw[dt_][4 * i_] = w_.x; rw[dt_][4 * i_ + 1] = w_.y; rw[dt_][4 * i_ + 2] = w_.z; rw[dt_][4 * i_ + 3] = w_.w; } } \
        { const bf16* vs_ = px + (rb_ + t0_ + s_) * NIN + C_MV + h_ * 128 + cg8_ * 16; rv0 = *(const u32x4*)vs_; rv1 = *(const u32x4*)(vs_ + 8); } \
        if (tid < 64) { const float* g_ = gates + (rb_ + t0_ + tid) * 16; rg0 = g_[h_] + a.b_gates[h_]; rg1 = g_[4 + h_] + a.b_gates[4 + h_]; rg2 = g_[8 + h_] + a.b_gates[8 + h_]; rg3 = g_[12 + h_] + a.b_gates[12 + h_]; } } while (0)
    int unit = blockIdx.x;
    if (unit < NU) ML3_LOAD(unit);
    for (; unit < NU; unit += G) {
        const int h = unit & 3, bc = unit >> 2, c36 = bc % NCH, b = bc / NCH;
        const int t0 = c36 < 4 ? c36 * 64 : (c36 - 4) * 64;
        const size_t rowbase = c36 < 4 ? (size_t)(MX + b * CTXL) : (size_t)(b * SEQ);
        const int bhdF = (b * 4 + h) * 2, bhdB = bhdF + 1;
        __syncthreads();
        if (tid < 64) {
            const float lf = logsig(rg1), lb = logsig(rg3);
            const float totf = wave_sum(lf), totb = wave_sum(lb);
            const float sf = totf - scan_sum_up(lf, lane), pb = scan_sum_up(lb, lane) - lb;
            const float gf = sf + rg0, gb = pb + rg2;
            const float mf = wave_max(gf), mb = wave_max(gb);
            gl[256 + tid] = expf(gf - mf); gl[320 + tid] = expf(gb - mb);
            if (tid == 0) { scal[(bhdF * NCH + c36) * 2] = mf; scal[(bhdF * NCH + c36) * 2 + 1] = totf; scal[(bhdB * NCH + c36) * 2] = mb; scal[(bhdB * NCH + c36) * 2 + 1] = totb; } }
        { const int s = tid >> 3, cg8 = tid & 7, isk = cg8 >> 2, c0 = (cg8 & 3) * 16;
          float acc[16];
#pragma unroll
          for (int i = 0; i < 16; ++i) acc[i] = 0.f;
#pragma unroll
          for (int dt = 0; dt < 3; ++dt)
#pragma unroll
              for (int hq = 0; hq < 2; ++hq)
#pragma unroll
                  for (int i = 0; i < 4; ++i) { const unsigned w = rc[dt][hq][i]; acc[hq * 8 + 2 * i] += rw[dt][hq * 8 + 2 * i] * bflo(w); acc[hq * 8 + 2 * i + 1] += rw[dt][hq * 8 + 2 * i + 1] * bfhi(w); }
          const float qs = isk ? 1.0f : 0.125f;
#pragma unroll
          for (int i = 0; i < 16; ++i) { const float v = acc[i]; acc[i] = qs * v * frcp(1.0f + fexp(-v)); }
          u32x4 o0, o1;
#pragma unroll
          for (int i = 0; i < 4; ++i) { o0[i] = pk2(acc[2 * i], acc[2 * i + 1]); o1[i] = pk2(acc[8 + 2 * i], acc[8 + 2 * i + 1]); }
          bf16* dst = qks + (rowbase + t0 + s) * 512 + isk * 256 + h * 64 + c0; *(u32x4*)dst = o0; *(u32x4*)(dst + 8) = o1;
          if (isk) { *(LAS u32x4*)(Kn + s * 72 + c0) = o0; *(LAS u32x4*)(Kn + s * 72 + c0 + 8) = o1; } }
        __syncthreads();
        { const int s = tid >> 3, vg = tid & 7; const float wf = gl[256 + s], wb = gl[320 + s];
#pragma unroll
          for (int hq = 0; hq < 2; ++hq) { const u32x4 w = hq ? rv1 : rv0; u32x4 of, ob;
#pragma unroll
              for (int i = 0; i < 4; ++i) { const float v0 = bflo(w[i]), v1 = bfhi(w[i]); of[i] = cvtpk(v0 * wf, v1 * wf); ob[i] = cvtpk(v0 * wb, v1 * wb); }
              *(LAS u32x4*)(WV + s * 136 + vg * 16 + hq * 8) = of; *(LAS u32x4*)(WV + (64 + s) * 136 + vg * 16 + hq * 8) = ob; } }
        __syncthreads();
        if (unit + G < NU) ML3_LOAD(unit + G);
#pragma unroll
        for (int dir = 0; dir < 2; ++dir) { bf16* dst = stC + ((size_t)((bhdF + dir) * NCH + c36)) * 8192;
            const LAS bf16* wvb = WV + dir * 64 * 136 + wave * 16;
            const bf16x8 av0 = tr8(wvb + (fq * 8) * 136, wvb + (fq * 8 + 4) * 136, 136, lane), av1 = tr8(wvb + (32 + fq * 8) * 136, wvb + (32 + fq * 8 + 4) * 136, 136, lane);
#pragma unroll
            for (int dt = 0; dt < 4; ++dt) { f32x4 acc = mfma16(tr8(Kn + (fq * 8) * 72 + dt * 16, Kn + (fq * 8 + 4) * 72 + dt * 16, 72, lane), av0, (f32x4){0.f, 0.f, 0.f, 0.f});
                acc = mfma16(tr8(Kn + (32 + fq * 8) * 72 + dt * 16, Kn + (32 + fq * 8 + 4) * 72 + dt * 16, 72, lane), av1, acc);
                u32x2 o; o.x = cvtpk(acc[0], acc[1]); o.y = cvtpk(acc[2], acc[3]);
                *(u32x2*)(dst + (wave * 16 + fr) * 64 + dt * 16 + fq * 4) = o; } }
        { const int d = tid >> 3, part = tid & 7; float sF = 0.f, sB = 0.f;
#pragma unroll
          for (int i = 0; i < 8; ++i) { const int u = part * 8 + i; const float kv = bf2f(Kn[u * 72 + d]); sF += gl[256 + u] * kv; sB += gl[320 + u] * kv; }
          sF += __shfl_xor(sF, 1); sF += __shfl_xor(sF, 2); sF += __shfl_xor(sF, 4); sB += __shfl_xor(sB, 1); sB += __shfl_xor(sB, 2); sB += __shfl_xor(sB, 4);
          if (part == 0) { stN[(size_t)(bhdF * NCH + c36) * 64 + d] = sF; stN[(size_t)(bhdB * NCH + c36) * 64 + d] = sB; } }
    }
#undef ML3_LOAD
}

__device__ __forceinline__ void phase4(const Args& a, int tid, int G) {
    unsigned char* ws = a.ws; const bf16* stC = (const bf16*)(ws + WS_ST); const float* stN = (const float*)(ws + WS_STN); const float* scal = (const float*)(ws + WS_SCAL); float* mprev = (float*)(ws + WS_SCAL + 65536);
    bf16* cpC = (bf16*)(ws + WS_CP); float* cpN = (float*)(ws + WS_NP);
    for (int idx = blockIdx.x * NTHR + tid; idx < 64 * 2048; idx += G * NTHR) { const int bhd = idx >> 11, e = idx & 2047, dir = bhd & 1; const bool hasn = e < 16;
        float m = 0.f; f32x4 C = (f32x4){0.f, 0.f, 0.f, 0.f}, N = C;
        for (int s0 = 0; s0 < NCH; s0 += 12) { u32x2 dd[12]; f32x4 dn[12]; float ml[12], bl[12];
#pragma unroll
            for (int i = 0; i < 12; ++i) { const int step = s0 + i; const int c36 = dir == 0 ? step : (step < 4 ? 3 - step : 39 - step); const size_t en = (size_t)(bhd * NCH + c36);
                dd[i] = __builtin_nontemporal_load((const u32x2*)(stC + en * 8192 + e * 4)); ml[i] = scal[en * 2]; bl[i] = scal[en * 2 + 1];
                dn[i] = hasn ? *(const f32x4*)(stN + en * 64 + e * 4) : (f32x4){0.f, 0.f, 0.f, 0.f}; }
#pragma unroll
            for (int i = 0; i < 12; ++i) { const int step = s0 + i; const int c36 = dir == 0 ? step : (step < 4 ? 3 - step : 39 - step); const size_t en = (size_t)(bhd * NCH + c36);
                if (c36 >= 4) { u32x2 o; o.x = cvtpk(C.x, C.y); o.y = cvtpk(C.z, C.w); *(u32x2*)(cpC + en * 8192 + e * 4) = o;
                    if (hasn) *(f32x4*)(cpN + en * 64 + e * 4) = N; if (e == 0) mprev[en] = m; }
                const float mn = fmaxf(bl[i] + m, ml[i]); const float dec = expf(bl[i] + m - mn), sc = expf(ml[i] - mn);
                const f32x4 d0 = (f32x4){bflo(dd[i].x), bfhi(dd[i].x), bflo(dd[i].y), bfhi(dd[i].y)};
                C = dec * C + sc * d0; N = dec * N + sc * dn[i]; m = mn; } } }
}

__device__ __forceinline__ void phase5(const Args& a, LAS unsigned char* lds, int tid, int lane, int wave, int G) {
    unsigned char* ws = a.ws; const bf16* px = (const bf16*)(ws + WS_PX); const float* gates = (const float*)(ws + WS_GATES);
    const bf16* qks = (const bf16*)(ws + WS_QKS); const bf16* stC = (const bf16*)(ws + WS_CP); const float* stN = (const float*)(ws + WS_NP);
    const float* mprev = (const float*)(ws + WS_SCAL + 65536); bf16* mixcat = (bf16*)(ws + WS_A);
    LAS float* gl = (LAS float*)lds;
    LAS bf16* Qs = (LAS bf16*)(lds + 8192);
    LAS bf16* Ks = (LAS bf16*)(lds + 8192 + 9216);
    LAS bf16* Vn = (LAS bf16*)(lds + 8192 + 18432);
    LAS bf16* CF = (LAS bf16*)(lds + 8192 + 36864);
    LAS bf16* CB = (LAS bf16*)(lds + 8192 + 55296);
    LAS bf16* SF = (LAS bf16*)(lds + 8192 + 73728);
    LAS bf16* SB = (LAS bf16*)(lds + 8192 + 82944);
    enum { ROWF = 256, ROWB = 320, CCF = 384, CCB = 448, WIF = 512, WIB = 576, LOWF = 640, LOWB = 704, NF = 768, NBK = 832, QNF = 896, QNB = 960, RSP = 1024, SSQ = 1536 };
    const int fr = lane & 15, fq = lane >> 4;
    constexpr int NU = NB * 32 * 4;
    u32x4 rq, rk, rv0, rv1, rcf0, rcf1, rcb0, rcb1; float rgi = 0.f, rgf = 0.f, rn = 0.f, rmpF = 0.f, rmpB = 0.f;
#define ML5_LOAD(unit_) do { const int u_ = (unit_); const int h_ = u_ & 3, bc_ = u_ >> 2, c_ = bc_ & 31, b_ = bc_ >> 5; const size_t row0_ = (size_t)(b_ * SEQ + c_ * 64); const int bhd_ = (b_ * 4 + h_) * 2; \
        const size_t eF_ = (size_t)(bhd_ * NCH + c_ + 4), eB_ = (size_t)((bhd_ + 1) * NCH + c_ + 4); \
        { const int s_ = tid >> 3, ck_ = tid & 7; const bf16* src_ = qks + (row0_ + s_) * 512 + h_ * 64 + ck_ * 8; rq = __builtin_nontemporal_load((const u32x4*)src_); rk = __builtin_nontemporal_load((const u32x4*)(src_ + 256)); \
          const bf16* vs_ = px + (row0_ + s_) * NIN + C_MV + h_ * 128 + ck_ * 8; rv0 = *(const u32x4*)vs_; rv1 = *(const u32x4*)(vs_ + 64); } \
        { const int v_ = tid >> 2, dq_ = tid & 3; const bf16* sf_ = stC + eF_ * 8192 + v_ * 64 + dq_ * 8; const bf16* sb_ = stC + eB_ * 8192 + v_ * 64 + dq_ * 8; \
          rcf0 = __builtin_nontemporal_load((const u32x4*)sf_); rcf1 = __builtin_nontemporal_load((const u32x4*)(sf_ + 32)); rcb0 = __builtin_nontemporal_load((const u32x4*)sb_); rcb1 = __builtin_nontemporal_load((const u32x4*)(sb_ + 32)); } \
        if (tid < 128) { const int t_ = tid & 63, db_ = tid >> 6; const float* g_ = gates + (row0_ + t_) * 16; rgf = g_[(db_ ? 12 : 4) + h_] + a.b_gates[(db_ ? 12 : 4) + h_]; rgi = g_[(db_ ? 8 : 0) + h_] + a.b_gates[(db_ ? 8 : 0) + h_]; } \
        else if (tid < 256) { const int dir_ = (tid - 128) >> 6, d_ = tid & 63; rn = stN[(dir_ ? eB_ : eF_) * 64 + d_]; } \
        rmpF = mprev[eF_]; rmpB = mprev[eB_]; } while (0)
    int unit = blockIdx.x;
    if (unit < NU) ML5_LOAD(unit);
    for (; unit < NU; unit += G) {
        const int h = unit & 3, bc = unit >> 2, c = bc & 31, b = bc >> 5;
        const size_t row0 = (size_t)(b * SEQ + c * 64);
        __syncthreads();
        if (tid < 64) { const int t = tid;
            const float lf = logsig(rgf), bt = scan_sum_up(lf, lane), ct = rgi - bt, pmax = scan_max_up(ct, lane);
            const float mt = bt + fmaxf(rmpF, pmax); gl[ROWF + t] = bt - mt; gl[CCF + t] = ct; gl[WIF + t] = expf(bt + rmpF - mt); gl[LOWF + t] = expf(-mt); }
        else if (tid < 128) { const int t = tid - 64;
            const float lb = logsig(rgf), bt = scan_sum_down(lb, lane), ct = rgi - bt, pmax = scan_max_down(ct, lane);
            const float mt = bt + fmaxf(rmpB, pmax); gl[ROWB + t] = bt - mt; gl[CCB + t] = ct; gl[WIB + t] = expf(bt + rmpB - mt); gl[LOWB + t] = expf(-mt); }
        else if (tid < 256) { gl[NF + (tid - 128)] = rn; }
        { const int s = tid >> 3, ck = tid & 7;
          *(LAS u32x4*)(Qs + s * 72 + ck * 8) = rq; *(LAS u32x4*)(Ks + s * 72 + ck * 8) = rk;
          *(LAS u32x4*)(Vn + s * 136 + ck * 8) = rv0; *(LAS u32x4*)(Vn + s * 136 + 64 + ck * 8) = rv1; }
        { const int v = tid >> 2, dq = tid & 3;
          *(LAS u32x4*)(CF + v * 72 + dq * 8) = rcf0; *(LAS u32x4*)(CF + v * 72 + 32 + dq * 8) = rcf1; *(LAS u32x4*)(CB + v * 72 + dq * 8) = rcb0; *(LAS u32x4*)(CB + v * 72 + 32 + dq * 8) = rcb1; }
        __syncthreads();
        const int tt = wave & 3, vh = wave >> 2;
        unsigned short mor[4][4];
#pragma unroll
        for (int j = 0; j < 4; ++j)
#pragma unroll
            for (int vt = 0; vt < 4; ++vt) mor[j][vt] = px[(row0 + tt * 16 + fq * 4 + j) * NIN + C_MO + h * 128 + vh * 64 + vt * 16 + fr];
        if (unit + G < NU) ML5_LOAD(unit + G);
        { const int t = tid >> 3, part = tid & 7; const u32x4 qw = *(const LAS u32x4*)(Qs + t * 72 + part * 8); float sF = 0.f, sB = 0.f;
#pragma unroll
          for (int i = 0; i < 4; ++i) { const float q0 = bflo(qw[i]), q1 = bfhi(qw[i]); const int d = part * 8 + 2 * i;
              sF += gl[NF + d] * q0 + gl[NF + d + 1] * q1; sB += gl[NBK + d] * q0 + gl[NBK + d + 1] * q1; }
          sF += __shfl_xor(sF, 1); sF += __shfl_xor(sF, 2); sF += __shfl_xor(sF, 4); sB += __shfl_xor(sB, 1); sB += __shfl_xor(sB, 2); sB += __shfl_xor(sB, 4);
          if (part == 0) { gl[QNF + t] = sF; gl[QNB + t] = sB; } }
        {
#pragma unroll
          for (int q = 0; q < 2; ++q) { const int stl = (wave >> 2) * 2 + q; f32x4 acc = (f32x4){0.f, 0.f, 0.f, 0.f};
#pragma unroll
              for (int kk = 0; kk < 2; ++kk) acc = mfma16(*(const LAS bf16x8*)(Qs + (tt * 16 + fr) * 72 + kk * 32 + fq * 8), *(const LAS bf16x8*)(Ks + (stl * 16 + fr) * 72 + kk * 32 + fq * 8), acc);
              const int s = stl * 16 + fr; const float cf = gl[CCF + s], cb = gl[CCB + s];
#pragma unroll
              for (int j = 0; j < 4; ++j) { const int t = tt * 16 + fq * 4 + j;
                  const float wF = (s <= t) ? fexp(gl[ROWF + t] + cf) : 0.f, wB = (s >= t) ? fexp(gl[ROWB + t] + cb) : 0.f;
                  const float sf = acc[j] * wF, sb = acc[j] * wB;
                  SF[t * 72 + s] = (bf16)f2bf(sf); SB[t * 72 + s] = (bf16)f2bf(sb);
                  const float rf = red16_sum(sf), rb = red16_sum(sb);
                  if (fr == 0) { gl[RSP + t * 4 + stl] = rf; gl[RSP + 256 + t * 4 + stl] = rb; } } } }
        __syncthreads();
        { f32x4 aS[2][4], aI[2][4];
#pragma unroll
          for (int dir = 0; dir < 2; ++dir)
#pragma unroll
              for (int vt = 0; vt < 4; ++vt) { aS[dir][vt] = (f32x4){0.f, 0.f, 0.f, 0.f}; aI[dir][vt] = (f32x4){0.f, 0.f, 0.f, 0.f}; }
#pragma unroll
          for (int kk = 0; kk < 2; ++kk) { const bf16x8 qa = *(const LAS bf16x8*)(Qs + (tt * 16 + fr) * 72 + kk * 32 + fq * 8);
              const bf16x8 sfa = *(const LAS bf16x8*)(SF + (tt * 16 + fr) * 72 + kk * 32 + fq * 8), sba = *(const LAS bf16x8*)(SB + (tt * 16 + fr) * 72 + kk * 32 + fq * 8);
#pragma unroll
              for (int vt = 0; vt < 4; ++vt) { const int vrow = (vh * 64 + vt * 16 + fr) * 72 + kk * 32 + fq * 8;
                  const bf16x8 vb = tr8(Vn + (kk * 32 + fq * 8) * 136 + vh * 64 + vt * 16, Vn + (kk * 32 + fq * 8 + 4) * 136 + vh * 64 + vt * 16, 136, lane);
                  aS[0][vt] = mfma16(sfa, vb, aS[0][vt]); aS[1][vt] = mfma16(sba, vb, aS[1][vt]);
                  aI[0][vt] = mfma16(qa, *(const LAS bf16x8*)(CF + vrow), aI[0][vt]); aI[1][vt] = mfma16(qa, *(const LAS bf16x8*)(CB + vrow), aI[1][vt]); } }
          float hv[4][4];
#pragma unroll
          for (int j = 0; j < 4; ++j) { const int t = tt * 16 + fq * 4 + j;
              const float wiF = gl[WIF + t], wiB = gl[WIB + t];
              const float denF = (gl[RSP + t * 4] + gl[RSP + t * 4 + 1]) + (gl[RSP + t * 4 + 2] + gl[RSP + t * 4 + 3]) + wiF * gl[QNF + t];
              const float denB = (gl[RSP + 256 + t * 4] + gl[RSP + 256 + t * 4 + 1]) + (gl[RSP + 256 + t * 4 + 2] + gl[RSP + 256 + t * 4 + 3]) + wiB * gl[QNB + t];
              const float iF = frcp(fmaxf(fabsf(denF), gl[LOWF + t])), iB = frcp(fmaxf(fabsf(denB), gl[LOWB + t]));
              float ss = 0.f;
#pragma unroll
              for (int vt = 0; vt < 4; ++vt) { const float hval = (aS[0][vt][j] + wiF * aI[0][vt][j]) * iF + (aS[1][vt][j] + wiB * aI[1][vt][j]) * iB; hv[vt][j] = hval; ss += hval * hval; }
              ss = red16_sum(ss);
              if (fr == 0) gl[SSQ + t * 2 + vh] = ss; }
          __syncthreads();
#pragma unroll
          for (int j = 0; j < 4; ++j) { const int t = tt * 16 + fq * 4 + j; const float rms = rsqrtf((gl[SSQ + t * 2] + gl[SSQ + t * 2 + 1]) * (1.0f / 128.0f) + EPSF);
              bf16* orow = mixcat + (row0 + t) * D + 512 + h * 128 + vh * 64 + fr;
#pragma unroll
              for (int vt = 0; vt < 4; ++vt) { const float o = bf2f(mor[j][vt]); const float y = hv[vt][j] * rms * a.g_ml[h * 128 + vh * 64 + vt * 16 + fr];
                  orow[vt * 16] = (bf16)(cvtpk(y * frcp(1.0f + fexp(-o)), 0.f) & 0xffffu); } } }
    }
#undef ML5_LOAD
}

__device__ __forceinline__ void phase7(const Args& a, int lane, int wave, int G) {
    unsigned char* ws = a.ws; const float* mod = (const float*)(ws + WS_MOD); const bf16* mix = (const bf16*)(ws + WS_MIX); bf16* A = (bf16*)(ws + WS_A);
    const int gw = blockIdx.x * NWAVES + wave, NGW = G * NWAVES;
    for (int r0 = gw * 8; r0 < MX; r0 += NGW * 8) { const float* mrow = mod + (r0 >> 11) * 6144;
        f32x4 g1[4], gt[4], g2[4], sh[4], sc[4];
#pragma unroll
        for (int j = 0; j < 4; ++j) { const int k = 4 * lane + 256 * j; g1[j] = *(const f32x4*)(a.g_post_mix + k); gt[j] = *(const f32x4*)(mrow + 2048 + k); g2[j] = *(const f32x4*)(a.g_pre_ffn + k);
            sh[j] = *(const f32x4*)(mrow + 3072 + k); sc[j] = *(const f32x4*)(mrow + 4096 + k) + 1.0f; }
        u32x2 nm[4]; f32x4 nx[4];
#pragma unroll
        for (int j = 0; j < 4; ++j) { nm[j] = __builtin_nontemporal_load((const u32x2*)(mix + (size_t)r0 * D + 4 * lane + 256 * j)); nx[j] = __builtin_nontemporal_load((const f32x4*)(a.x + (size_t)r0 * D + 4 * lane + 256 * j)); }
        for (int row = r0; row < r0 + 8; ++row) {
            f32x4 v[4], xv[4]; float ss = 0.f;
#pragma unroll
            for (int j = 0; j < 4; ++j) { const u32x2 w = nm[j]; xv[j] = nx[j]; v[j] = (f32x4){bflo(w.x), bfhi(w.x), bflo(w.y), bfhi(w.y)};
                ss += (v[j].x * v[j].x + v[j].y * v[j].y) + (v[j].z * v[j].z + v[j].w * v[j].w); }
            if (row + 1 < r0 + 8) {
#pragma unroll
                for (int j = 0; j < 4; ++j) { nm[j] = __builtin_nontemporal_load((const u32x2*)(mix + (size_t)(row + 1) * D + 4 * lane + 256 * j)); nx[j] = __builtin_nontemporal_load((const f32x4*)(a.x + (size_t)(row + 1) * D + 4 * lane + 256 * j)); } }
            const float rstd = rsqrtf(wave_sum(ss) * (1.0f / D) + EPSF);
            float s2 = 0.f;
#pragma unroll
            for (int j = 0; j < 4; ++j) { const int k = 4 * lane + 256 * j;
                v[j] = xv[j] + gt[j] * ((v[j] * rstd) * g1[j]);
                s2 += (v[j].x * v[j].x + v[j].y * v[j].y) + (v[j].z * v[j].z + v[j].w * v[j].w); }
            const float rstd2 = rsqrtf(wave_sum(s2) * (1.0f / D) + EPSF);
#pragma unroll
            for (int j = 0; j < 4; ++j) { const int k = 4 * lane + 256 * j;
                const f32x4 y = ((v[j] * rstd2) * g2[j]) * sc[j] + sh[j]; u32x2 o; o.x = cvtpk(y.x, y.y); o.y = cvtpk(y.z, y.w); *(u32x2*)(A + (size_t)row * D + k) = o; } } }
}
__device__ __forceinline__ void phase10(const Args& a, int lane, int wave, int G) {
    unsigned char* ws = a.ws; const float* mod = (const float*)(ws + WS_MOD); const bf16* fx = (const bf16*)(ws + WS_FX); const bf16* mix = (const bf16*)(ws + WS_MIX);
    const int gw = blockIdx.x * NWAVES + wave, NGW = G * NWAVES;
    for (int r0 = gw * 8; r0 < MX; r0 += NGW * 8) { const float* mrow = mod + (r0 >> 11) * 6144;
        f32x4 g1[4], gt[4], gm[4], gtm[4];
#pragma unroll
        for (int j = 0; j < 4; ++j) { const int k = 4 * lane + 256 * j; g1[j] = *(const f32x4*)(a.g_post_ffn + k); gt[j] = *(const f32x4*)(mrow + 5120 + k);
            gm[j] = *(const f32x4*)(a.g_post_mix + k); gtm[j] = *(const f32x4*)(mrow + 2048 + k); }
        u32x2 nm[4], nq[4]; f32x4 nx[4];
#pragma unroll
        for (int j = 0; j < 4; ++j) { const size_t o = (size_t)r0 * D + 4 * lane + 256 * j; nm[j] = __builtin_nontemporal_load((const u32x2*)(fx + o)); nq[j] = __builtin_nontemporal_load((const u32x2*)(mix + o)); nx[j] = __builtin_nontemporal_load((const f32x4*)(a.x + o)); }
        for (int row = r0; row < r0 + 8; ++row) {
            f32x4 v[4], q[4], xv[4]; float ss = 0.f, sq = 0.f;
#pragma unroll
            for (int j = 0; j < 4; ++j) { const u32x2 w = nm[j], u = nq[j]; xv[j] = nx[j]; v[j] = (f32x4){bflo(w.x), bfhi(w.x), bflo(w.y), bfhi(w.y)}; q[j] = (f32x4){bflo(u.x), bfhi(u.x), bflo(u.y), bfhi(u.y)};
                ss += (v[j].x * v[j].x + v[j].y * v[j].y) + (v[j].z * v[j].z + v[j].w * v[j].w); sq += (q[j].x * q[j].x + q[j].y * q[j].y) + (q[j].z * q[j].z + q[j].w * q[j].w); }
            if (row + 1 < r0 + 8) {
#pragma unroll
                for (int j = 0; j < 4; ++j) { const size_t o = (size_t)(row + 1) * D + 4 * lane + 256 * j; nm[j] = __builtin_nontemporal_load((const u32x2*)(fx + o)); nq[j] = __builtin_nontemporal_load((const u32x2*)(mix + o)); nx[j] = __builtin_nontemporal_load((const f32x4*)(a.x + o)); } }
            const float rstd = rsqrtf(wave_sum(ss) * (1.0f / D) + EPSF), rstdq = rsqrtf(wave_sum(sq) * (1.0f / D) + EPSF);
#pragma unroll
            for (int j = 0; j < 4; ++j) { const int k = 4 * lane + 256 * j;
                const f32x4 x1 = xv[j] + gtm[j] * ((q[j] * rstdq) * gm[j]);
                *(f32x4*)(a.out + (size_t)row * D + k) = x1 + gt[j] * ((v[j] * rstd) * g1[j]); } } }
}

#include <cstdlib>
#include <vector>

#define XB_TMO      128
#define XB_XCNT(j)  (256  + 64 * (j))
#define XB_XSUB(j)  (1280 + 64 * (j))
#define XB_XGEN(j)  (2304 + 64 * (j))
#define XB_TOP      3328
#define XB_TOPGEN   3392
#define XCD_BAR_WORDS 3456
#define XB_SPIN_CAP (1u << 18)
__device__ __forceinline__ unsigned xb_ld(unsigned* p)              { return __hip_atomic_load(p, __ATOMIC_RELAXED, __HIP_MEMORY_SCOPE_AGENT); }
__device__ __forceinline__ unsigned xb_add(unsigned* p, unsigned v) { return __hip_atomic_fetch_add(p, v, __ATOMIC_RELAXED, __HIP_MEMORY_SCOPE_AGENT); }
__device__ __forceinline__ unsigned xb_xcc_id() { return (unsigned)__builtin_amdgcn_s_getreg((3 << 11) | 20) & 0xFu; }
#define XB_SPIN(cond, bar) do { unsigned _sp = 0; while (cond) { __builtin_amdgcn_s_sleep(1); \
    if ((++_sp & 255u) == 0u) { if (xb_ld(&(bar)[XB_TMO])) break; if (_sp > XB_SPIN_CAP) { atomicAdd(&(bar)[XB_TMO], 1u); break; } } } } while (0)

struct XcdBarrier {
    unsigned* bar; unsigned x;
    volatile LAS unsigned* st;
};

__device__ __forceinline__ XcdBarrier xcd_barrier_post(unsigned* bar, volatile LAS unsigned* st) {
    XcdBarrier b; b.bar = bar; b.x = xb_xcc_id(); b.st = st;
    if (threadIdx.x == 0) (void)xb_add(&bar[XB_XCNT(b.x)], 1u);
    return b;
}
__device__ __forceinline__ void xcd_barrier_complete(unsigned* bar, unsigned x, unsigned& nloc, unsigned& nx) {
    const unsigned G = gridDim.x * gridDim.y * gridDim.z;
    unsigned sum, cnt, mine, sp = 0u;
    for (;;) {
        sum = 0u; cnt = 0u; mine = 0u;
#pragma unroll
        for (unsigned j = 0; j < 16; ++j) { const unsigned c = xb_ld(&bar[XB_XCNT(j)]); sum += c; cnt += (c > 0u) ? 1u : 0u; mine = (j == x) ? c : mine; }
        if (sum == G) break;
        __builtin_amdgcn_s_sleep(1);
        if ((++sp & 255u) == 0u) { if (xb_ld(&bar[XB_TMO])) break; if (sp > XB_SPIN_CAP) { atomicAdd(&bar[XB_TMO], 1u); break; } }
    }
    nloc = mine > 0u ? mine : 1u; nx = cnt > 0u ? cnt : 1u;
}

__device__ __forceinline__ void xcd_barrier(const XcdBarrier& b) {
    asm volatile("s_waitcnt vmcnt(0)" ::: "memory");
    __syncthreads();
    if (threadIdx.x == 0) {
        unsigned* bar = b.bar;
        __builtin_amdgcn_s_waitcnt(0);
        unsigned nloc = b.st[0], nx = b.st[1];
        if (nloc == 0u) { xcd_barrier_complete(bar, b.x, nloc, nx); b.st[0] = nloc; b.st[1] = nx; }
        const unsigned old = xb_add(&bar[XB_XSUB(b.x)], 1u);
        const unsigned gen = old / nloc;
        if (old + 1u == (gen + 1u) * nloc) {
            __builtin_amdgcn_fence(__ATOMIC_RELEASE, "agent");
            asm volatile("s_waitcnt vmcnt(0)" ::: "memory");
            const unsigned og = xb_add(&bar[XB_TOP], 1u);
            const unsigned tg = og / nx;
            if (og + 1u == (tg + 1u) * nx) xb_add(&bar[XB_TOPGEN], 1u);
            else XB_SPIN(xb_ld(&bar[XB_TOPGEN]) == tg, bar);
            __builtin_amdgcn_fence(__ATOMIC_ACQUIRE, "agent");
            xb_add(&bar[XB_XGEN(b.x)], 1u);
            asm volatile("s_waitcnt vmcnt(0)" ::: "memory");
        } else {
            XB_SPIN(xb_ld(&bar[XB_XGEN(b.x)]) == gen, bar);
            __builtin_amdgcn_fence(__ATOMIC_ACQUIRE, "agent");
            asm volatile("s_waitcnt vmcnt(0)" ::: "memory");
        }
    }
    __syncthreads();
}

__global__ void __launch_bounds__(NTHR, 2) fwd_kernel(Args a) {
    extern __shared__ __attribute__((aligned(16))) unsigned char lds_raw[];
    LAS unsigned char* lds = (LAS unsigned char*)lds_raw;
    cg::grid_group grid = cg::this_grid();
    const int tid = threadIdx.x, lane = tid & 63, wave = __builtin_amdgcn_readfirstlane(tid >> 6), G = gridDim.x;
    const int lo = a.ph_lo, hi = a.ph_hi;
    unsigned char* ws = a.ws;
#ifndef PHASE_MASK
#define PHASE_MASK 0x7ff
#endif
#define IN(k) (((PHASE_MASK >> (k)) & 1) && lo <= (k) && (k) < hi)
#define SEAM(k) do { if (IN(k) && IN((k) + 1)) { xcd_barrier(xbar); } } while (0)
    if (tid < 4) ((LAS unsigned*)(lds + 131072))[tid] = 0u;
    __syncthreads();
    XcdBarrier xbar = xcd_barrier_post((unsigned*)ws, (volatile LAS unsigned*)(lds + 131072));
    if (lo > 1000) grid.sync();
#ifdef TSA
    unsigned long long tsa = 0, tsb = 0;
#define STAMP(i) do { if ((i) == TSA) tsa = __builtin_amdgcn_s_memrealtime(); if ((i) == TSB) tsb = __builtin_amdgcn_s_memrealtime(); } while (0)
#else
#define STAMP(i) do {} while (0)
#endif
    STAMP(0);
    if (IN(0)) { phase0(a, lds, tid, lane, wave, G); } STAMP(1);
    if (IN(1)) { phase1(a, lds, tid, lane, wave, G); } SEAM(1); STAMP(2);
    if (IN(2)) { __syncthreads(); pg8::Gemm g{(const pg8::bf16_t*)(ws + WS_A), (const pg8::bf16_t*)(ws + WS_WIN), MT, NIN + 256, D}; pg8::StaticOrder S; S.init(MT, NIN + 256, G, (int)blockIdx.x);
        pg8::EpiInProj E{(pg8::bf16_t*)(ws + WS_PX), NIN, (float*)(ws + WS_GATES)}; pg8::gemm_phase<pg8::EpiInProj, pg8::StaticOrder, true, true>(lds, g, S, E);
        __syncthreads(); transpose_by_idle(a, lds, TI_IN, TI_IN + TI_OUT, (72 * 10) % G, G, wave, lane);
        { const int first = (72 * 10) % G;
          __syncthreads();
          if (first <= 0 || first >= G) { for (int it = 32 + (int)blockIdx.x; it < 96; it += G) mod_item(a, lds, it, tid, lane, wave); }
          else { const int n2 = (G - first) < 64 ? (G - first) : 64, j = (int)blockIdx.x - first; if (j >= 0 && j < n2) mod_item(a, lds, 32 + j, tid, lane, wave); } } } SEAM(2); STAMP(3);
    if (IN(3)) { __syncthreads(); attn_stage_rope(a, lds, tid); if (G == 256) { for (int i = 0; i < 2; ++i) attn_unit(a, lds, (((int)blockIdx.x & 7) * 2 + i) * 32 + ((int)blockIdx.x >> 3), tid, lane, wave); }
        else { for (int u = blockIdx.x; u < 512; u += G) attn_unit(a, lds, u, tid, lane, wave); }
        STAMP(12);
        phase3_mllocal(a, lds, tid, lane, wave, G); } STAMP(13); SEAM(3); STAMP(4);
    if (IN(4)) { phase4(a, tid, G); transpose_by_idle(a, lds, TI_IN + TI_OUT, TI_IN + TI_OUT + TI_FI, 0, G, wave, lane); } SEAM(4); STAMP(5);
    if (IN(5)) { phase5(a, lds, tid, lane, wave, G); } SEAM(5); STAMP(6);
    if (IN(6)) { __syncthreads(); pg8::Gemm g{(const pg8::bf16_t*)(ws + WS_A), (const pg8::bf16_t*)(ws + WS_WOUT), MX, D, D}; pg8::StaticOrder S; S.init(MX, D, G, (int)blockIdx.x);
        pg8::EpiBf16 E{(pg8::bf16_t*)(ws + WS_MIX), D}; pg8::gemm_phase<pg8::EpiBf16, pg8::StaticOrder, true, true>(lds, g, S, E); } SEAM(6); STAMP(7);
    if (IN(7)) { phase7(a, lane, wave, G); } SEAM(7); STAMP(8);
    if (IN(8)) { __syncthreads(); pg8::Gemm g{(const pg8::bf16_t*)(ws + WS_A), (const pg8::bf16_t*)(ws + WS_WFI), MX, 2 * FF, D}; pg8::StaticOrder S; S.init(MX, 2 * FF, G, (int)blockIdx.x);
        pg8::EpiSwiglu E{(pg8::bf16_t*)(ws + WS_H), FF}; pg8::gemm_phase<pg8::EpiSwiglu, pg8::StaticOrder, true, true>(lds, g, S, E);
        __syncthreads();
        { const int first2 = (72 * 10) % G; const int n2 = (first2 <= 0 || first2 >= G) ? 64 : ((G - first2) < 64 ? (G - first2) : 64);
          const int R = 64 - n2, first8 = (64 * 22) % G;
          int tfirst = first8;
          if (R > 0) {
              if (first8 <= 0 || first8 >= G) { for (int it = 32 + n2 + (int)blockIdx.x; it < 96; it += G) mod_item(a, lds, it, tid, lane, wave); }
              else { const int n8 = G - first8, j = (int)blockIdx.x - first8; if (j >= 0) for (int it = 32 + n2 + j; it < 96; it += n8) mod_item(a, lds, it, tid, lane, wave);
                  const int ng = R < n8 ? R : n8; if (first8 + ng < G) tfirst = first8 + ng; } }
          __syncthreads();
          transpose_by_idle(a, lds, TI_IN + TI_OUT + TI_FI, TI_IN + TI_OUT + TI_FI + TI_FO, tfirst, G, wave, lane); } } SEAM(8); STAMP(9);
    if (IN(9)) { __syncthreads(); pg8::Gemm g{(const pg8::bf16_t*)(ws + WS_H), (const pg8::bf16_t*)(ws + WS_WFO), MX, D, FF}; pg8::StaticOrder S; S.init(MX, D, G, (int)blockIdx.x);
        pg8::EpiBf16 E{(pg8::bf16_t*)(ws + WS_FX), D}; pg8::gemm_phase<pg8::EpiBf16, pg8::StaticOrder, true, true>(lds, g, S, E); } SEAM(9); STAMP(10);
    if (IN(10)) { phase10(a, lane, wave, G); }
    STAMP(11);
#ifdef TSA
    __syncthreads(); if (blockIdx.x == 0 && tid == 0) { asm volatile("s_waitcnt vmcnt(0)" ::: "memory");
#ifdef TSTHR
        if ((float)(tsb - tsa) * 0.01f > TSTHR) a.out[0] = 100.0f;
#else
        a.out[0] = (float)(tsb - tsa) * 0.01f;
#endif
    }
#endif
#undef IN
#undef SEAM
}

#ifndef N_LAUNCH_MODE
#define N_LAUNCH_MODE 1
#endif
extern "C" void kernel_launch(void* const* d_in, const int* in_sizes, int n_in, void* d_out, int out_size, void* d_ws, size_t ws_size, hipStream_t stream) {
    static int grid = 0;
    if (grid == 0) {
        int dev = 0, cus = 0, per_cu = 0;
        hipGetDevice(&dev); hipDeviceGetAttribute(&cus, hipDeviceAttributeMultiprocessorCount, dev);
        if (hipFuncSetAttribute((const void*)fwd_kernel, hipFuncAttributeMaxDynamicSharedMemorySize, LDS_BYTES) != hipSuccess) { fprintf(stderr, "kernel_launch: hipFuncSetAttribute failed\n"); grid = -1; return; }
        if (hipOccupancyMaxActiveBlocksPerMultiprocessor(&per_cu, (const void*)fwd_kernel, NTHR, LDS_BYTES) != hipSuccess || per_cu < 1) { fprintf(stderr, "kernel_launch: occupancy query says %d\n", per_cu); per_cu = 1; }
        (void)hipGetLastError();
        grid = cus * 1;
        if (grid <= 0) grid = 256;
    }
    if (grid < 0) return;
    Args a{};
    const float** ap = (const float**)&a;
    for (int i = 0; i < 18; ++i) ap[i] = (const float*)d_in[i];
    a.out = (float*)d_out; a.ws = (unsigned char*)d_ws;
    if (hipMemsetAsync(d_ws, 0, 16384, stream) != hipSuccess) { fprintf(stderr, "kernel_launch: memset of barrier words failed\n"); return; }
#if N_LAUNCH_MODE == 1
    a.ph_lo = 0; a.ph_hi = 11;
    { void* args[] = {&a}; hipError_t e = hipLaunchCooperativeKernel((const void*)fwd_kernel, dim3(grid), dim3(NTHR), args, LDS_BYTES, stream);
      if (e != hipSuccess) fprintf(stderr, "cooperative launch failed: %s (grid %d)\n", hipGetErrorString(e), grid); }
#else
    for (int p = 0; p < 11; ++p) { a.ph_lo = p; a.ph_hi = p + 1; void* args[] = {&a};
        hipError_t e = hipLaunchCooperativeKernel((const void*)fwd_kernel, dim3(grid), dim3(NTHR), args, LDS_BYTES, stream);
        if (e != hipSuccess) { fprintf(stderr, "launch %d failed: %s (grid %d)\n", p, hipGetErrorString(e), grid); break; } }
#endif
}
```
